# Optimizing an MI355X kernel written in HIP

```python
import math
import jax, jax.numpy as jnp
from jax import lax
import numpy as np

D_MODEL = 1024
BATCH = 16
SEQ = 2048
DEPTH = 1
DEC_BATCH = 16
DEC_SEQ = 4096
PAST_LEN = 128

D_CONV = D_MODEL // 2
D_SSM = D_MODEL - D_CONV
D_MIX = D_CONV + D_SSM
CONV_HEADS = 8
SSM_GROUP = 16
SSM_GROUPS = D_SSM // SSM_GROUP
SSM_STATE = 64
D_IN = 3 * D_CONV + D_SSM
D_FF = 2816
EPS = 1e-6
DT_MIN = 1e-3
DT_MAX = 1e-1

kernel_name = "hymba_conv_s5_sandwich_encoder"


def rms_norm(x, g):
    xf = x.astype(jnp.float32)
    y = xf * lax.rsqrt(jnp.mean(xf * xf, axis=-1, keepdims=True) + EPS)
    return (y * g.astype(jnp.float32)).astype(x.dtype)


def dwconv3(x, w):
    L = x.shape[1]
    xp = jnp.pad(x, ((0, 0), (1, 1), (0, 0)))
    return xp[:, 0:L] * w[0] + xp[:, 1:L + 1] * w[1] + xp[:, 2:L + 2] * w[2]


def _linear_recurrence_combine(e1, e2):
    a1, b1 = e1
    a2, b2 = e2
    return (a1 * a2, a2 * b1 + b2)


def _s5_direction(u, lam_re, lam_im, log_step, b_re, b_im, c_re, c_im):
    L = u.shape[0]
    f32 = jnp.float32
    lam = lax.complex(lam_re.astype(f32), lam_im.astype(f32))
    dt = jnp.exp(log_step.astype(f32))[:, None]
    lam_bar = jnp.exp(lam * dt)
    bmat = lax.complex(b_re.astype(f32), b_im.astype(f32))
    b_bar = ((lam_bar - 1.0) / lam)[..., None] * bmat
    bu = jnp.einsum('lbgh,gph->lbgp', u.astype(jnp.complex64), b_bar)
    a = jnp.broadcast_to(lam_bar[None, None], (L, 1) + lam_bar.shape)
    _, s = lax.associative_scan(_linear_recurrence_combine, (a, bu), axis=0)
    cmat = lax.complex(c_re.astype(f32), c_im.astype(f32))
    return jnp.real(jnp.einsum('lbgp,ghp->lbgh', s, cmat))


def s5_mixer(u, lam_re, lam_im, log_step, b_re, b_im, c_re, c_im, d_skip, w_glu, b_glu):
    Bt, L, _ = u.shape
    uf = u.astype(jnp.float32)
    ul = uf.reshape(Bt, L, SSM_GROUPS, SSM_GROUP).transpose(1, 0, 2, 3)
    y_fwd = _s5_direction(ul, lam_re[0], lam_im[0], log_step[0], b_re[0], b_im[0], c_re[0], c_im[0])
    y_bwd = jnp.flip(_s5_direction(jnp.flip(ul, 0), lam_re[1], lam_im[1], log_step[1],
                                   b_re[1], b_im[1], c_re[1], c_im[1]), 0)
    y = (y_fwd + y_bwd).transpose(1, 0, 2, 3).reshape(Bt, L, D_SSM) + uf * d_skip.astype(jnp.float32)
    y = jax.nn.gelu(y).astype(u.dtype)
    return y * jax.nn.sigmoid(y @ w_glu + b_glu)


def encoder_layer(x, pre_mix_g, w_in, conv_w, lam_re, lam_im, log_step, b_re, b_im, c_re, c_im,
                  d_skip, w_glu, b_glu, gn_conv, gn_ssm, w_out, post_mix_g,
                  pre_ffn_g, w_up, ffn_conv_w, ffn_conv_b, w_down, post_ffn_g):
    h = rms_norm(x, pre_mix_g)
    z = h @ w_in
    zb = z[..., 0:D_CONV]
    zc = z[..., D_CONV:2 * D_CONV]
    zx = z[..., 2 * D_CONV:3 * D_CONV]
    zu = z[..., 3 * D_CONV:]
    y_conv = zb * dwconv3(zc * zx, conv_w)
    y_ssm = s5_mixer(zu, lam_re, lam_im, log_step, b_re, b_im, c_re, c_im, d_skip, w_glu, b_glu)
    y = jnp.concatenate([rms_norm(y_conv, gn_conv), rms_norm(y_ssm, gn_ssm)], axis=-1) @ w_out
    x = x + rms_norm(y, post_mix_g)
    h = rms_norm(x, pre_ffn_g)
    up = dwconv3(h @ w_up, ffn_conv_w) + ffn_conv_b
    gate = up[..., :D_FF]
    val = up[..., D_FF:]
    f = (jax.nn.silu(gate) * val) @ w_down
    return x + rms_norm(f, post_ffn_g)


def setup_inputs(seed: int = 0) -> dict:
    key = jax.random.key(seed)
    ks = jax.random.split(key, 32)
    f32 = jnp.float32
    nrm = lambda k, shape, s: jax.random.normal(k, shape, f32) * s
    gain = lambda k, n: 1.0 + 0.01 * jax.random.normal(k, (DEPTH, n), f32)
    G, P, H = SSM_GROUPS, SSM_STATE, SSM_GROUP
    n_idx = jnp.arange(P, dtype=f32)
    lam_re = -0.5 + 0.01 * jax.random.normal(ks[2], (DEPTH, 2, G, P), f32)
    lam_im = math.pi * n_idx + 0.01 * jax.random.normal(ks[3], (DEPTH, 2, G, P), f32)
    log_step = jax.random.uniform(ks[4], (DEPTH, 2, G), f32, math.log(DT_MIN), math.log(DT_MAX))
    return {
        "x_prompt": jax.random.normal(ks[0], (BATCH, SEQ, D_MODEL), f32),
        "x_sample": jax.random.normal(ks[1], (DEC_BATCH, DEC_SEQ, D_MODEL), f32),
        "pre_mix_g": gain(ks[5], D_MODEL),
        "w_in": nrm(ks[6], (DEPTH, D_MODEL, D_IN), D_MODEL ** -0.5),
        "conv_w": nrm(ks[7], (DEPTH, 3, D_CONV), 3 ** -0.5),
        "lam_re": lam_re,
        "lam_im": lam_im,
        "log_step": log_step,
        "b_re": nrm(ks[8], (DEPTH, 2, G, P, H), (2 * H) ** -0.5),
        "b_im": nrm(ks[9], (DEPTH, 2, G, P, H), (2 * H) ** -0.5),
        "c_re": nrm(ks[10], (DEPTH, 2, G, H, P), (2 * P) ** -0.5),
        "c_im": nrm(ks[11], (DEPTH, 2, G, H, P), (2 * P) ** -0.5),
        "d_skip": nrm(ks[12], (DEPTH, D_SSM), 1.0),
        "w_glu": nrm(ks[13], (DEPTH, D_SSM, D_SSM), D_SSM ** -0.5),
        "b_glu": nrm(ks[14], (DEPTH, D_SSM), 0.01),
        "gn_conv": gain(ks[15], D_CONV),
        "gn_ssm": gain(ks[16], D_SSM),
        "w_out": nrm(ks[17], (DEPTH, D_MIX, D_MODEL), D_MIX ** -0.5),
        "post_mix_g": gain(ks[18], D_MODEL),
        "pre_ffn_g": gain(ks[19], D_MODEL),
        "w_up": nrm(ks[20], (DEPTH, D_MODEL, 2 * D_FF), D_MODEL ** -0.5),
        "ffn_conv_w": nrm(ks[21], (DEPTH, 3, 2 * D_FF), 3 ** -0.5),
        "ffn_conv_b": nrm(ks[22], (DEPTH, 2 * D_FF), 0.01),
        "w_down": nrm(ks[23], (DEPTH, D_FF, D_MODEL), D_FF ** -0.5),
        "post_ffn_g": gain(ks[24], D_MODEL),
    }


def reference(x_prompt, x_sample, pre_mix_g, w_in, conv_w, lam_re, lam_im, log_step, b_re, b_im,
              c_re, c_im, d_skip, w_glu, b_glu, gn_conv, gn_ssm, w_out, post_mix_g,
              pre_ffn_g, w_up, ffn_conv_w, ffn_conv_b, w_down, post_ffn_g):
    def trunk(x):
        for l in range(DEPTH):
            x = encoder_layer(x, pre_mix_g[l], w_in[l], conv_w[l], lam_re[l], lam_im[l], log_step[l],
                              b_re[l], b_im[l], c_re[l], c_im[l], d_skip[l], w_glu[l], b_glu[l],
                              gn_conv[l], gn_ssm[l], w_out[l], post_mix_g[l],
                              pre_ffn_g[l], w_up[l], ffn_conv_w[l], ffn_conv_b[l], w_down[l], post_ffn_g[l])
        return x
    y_prompt = trunk(x_prompt)
    y_sample = trunk(x_sample)
    return (y_prompt, y_sample)
```

```cpp
#include <hip/hip_runtime.h>
#include <hip/hip_cooperative_groups.h>
#include <cstdio>
#include <cstdint>
namespace cg = cooperative_groups;

#define LAS __attribute__((address_space(3)))
typedef unsigned short bf16_t;
typedef short bf16x8 __attribute__((ext_vector_type(8)));
typedef float f32x4 __attribute__((ext_vector_type(4)));
typedef float f32x2 __attribute__((ext_vector_type(2)));
typedef unsigned u32x4 __attribute__((ext_vector_type(4)));
typedef unsigned u32x2 __attribute__((ext_vector_type(2)));

constexpr int NTOK = 98304, NPROMPT = 32768, DM = 1024, DZ3 = 1536, DFF = 2816, DUP = 5632;
constexpr int NCHUNK = 1536, UROW = 40960  , TPK = 1280;
constexpr float EPS = 1e-6f;
constexpr size_t MiB = 1u << 20;
constexpr size_t WS_WIN = 1 * MiB, WS_WGLU = 5 * MiB, WS_WOUT = 6 * MiB, WS_WUP = 8 * MiB, WS_WDN = 19 * MiB;
constexpr size_t WS_POW = 25 * MiB, WS_BBAR = 28 * MiB, WS_KT = 29 * MiB, WS_BIN = 33 * MiB, WS_TP = 49 * MiB;
constexpr size_t WS_H = 130 * MiB, WS_Z3 = 322 * MiB, WS_U = 610 * MiB, WS_ELOC = 730 * MiB, WS_YG = 778 * MiB, WS_YS = 874 * MiB;
constexpr size_t WS_YCAT = 130 * MiB, WS_Y = 322 * MiB, WS_H2 = 706 * MiB, WS_ACT = 25 * MiB, WS_EDGE = 898 * MiB, WS_F = 553 * MiB;
constexpr int LDS_BYTES = 147456, XB_OFF = 131072;

__device__ __forceinline__ unsigned f2bf(float f) { unsigned u = __builtin_bit_cast(unsigned, f); return (u + 0x7fffu + ((u >> 16) & 1u)) >> 16; }
__device__ __forceinline__ unsigned pk2(float lo, float hi) { return f2bf(lo) | (f2bf(hi) << 16); }
__device__ __forceinline__ float bflo(unsigned w) { return __builtin_bit_cast(float, w << 16); }
__device__ __forceinline__ float bfhi(unsigned w) { return __builtin_bit_cast(float, w & 0xffff0000u); }
__device__ __forceinline__ float wave_sum(float v) {
#pragma unroll
    for (int o = 1; o < 64; o <<= 1) v += __shfl_xor(v, o);
    return v;
}
__device__ __forceinline__ float sigmoidf_(float v) { return __builtin_amdgcn_rcpf(1.0f + __expf(-v)); }
__device__ __forceinline__ float gelu_tanh(float x) { const float u = 0.7978845608028654f * (x + 0.044715f * x * x * x); return x * sigmoidf_(2.0f * u); }
__device__ __forceinline__ void seqpos(int m, int& t, int& L) { if (m < NPROMPT) { t = m & 2047; L = 2048; } else { t = m & 4095; L = 4096; } }

namespace pg8 {
constexpr int BM = 256, BK = 64, HALF = 128, HTB = HALF * BK * 2, STAGE_BYTES = 8 * HTB, NXCD = 8, WGM = 8;
__host__ __device__ __forceinline__ int lds_byte(int r, int c) { const int st = (r >> 4) * 2 + (c >> 5), rr = r & 15, cc = c & 31, ob = rr * 64 + cc * 2; return st * 1024 + (ob ^ (((ob >> 9) & 1) << 5)); }
__host__ __device__ __forceinline__ void stage_rc(int b, int& R, int& C) { const int st = b / 1024, sb = b % 1024, swz = sb ^ (((sb >> 9) & 1) << 5); R = (st >> 1) * 16 + swz / 64; C = (st & 1) * 32 + (swz % 64) / 2; }
__host__ __device__ __forceinline__ int perm32(int rho) { const int n = rho >> 4, i = rho & 15; return 8 * (i >> 2) + 4 * n + (i & 3); }

struct Unit { int pm, pn, b; };
struct Gemm { const bf16_t* A; const bf16_t* Bt; int lda, K; size_t bsA, bsB; };

struct StaticOrder {
    int nM, nN, nwg, G, c;
    __device__ void init(int M, int N, int G_, int c_) { nM = M / BM; nN = N / BM; nwg = nM * nN; G = G_; c = c_; }
    __device__ bool next(int i, Unit& u) const {
        const long L = (long)i * G + c; if (L >= nwg) return false;
        int wgid = (int)L; { const int q = nwg / NXCD, r = nwg % NXCD, xcd = wgid % NXCD, off = wgid / NXCD; wgid = (xcd < r ? xcd * (q + 1) : r * (q + 1) + (xcd - r) * q) + off; }
        const int nig = WGM * nN, gid = wgid / nig, fm = gid * WGM, gsz = (nM - fm) < WGM ? (nM - fm) : WGM;
        u.pm = fm + ((wgid % nig) % gsz); u.pn = (wgid % nig) / gsz; u.b = 0; return true;
    }
};
struct BatchOrder {
    int nM, nN, per, total, G, c;
    __device__ void init(int nM_, int nN_, int nb, int G_, int c_) { nM = nM_; nN = nN_; per = nM_ * nN_; total = per * nb; G = G_; c = c_; }
    __device__ bool next(int i, Unit& u) const {
        const int L = i * G + c; if (L >= total) return false;
        u.b = L / per; const int r = L % per; u.pm = r % nM; u.pn = r / nM; return true;
    }
};

__device__ __forceinline__ unsigned cvt_pk_bf16(float lo, float hi) { unsigned r; asm volatile("v_cvt_pk_bf16_f32 %0, %1, %2" : "=v"(r) : "v"(lo), "v"(hi)); return r; }

template <class Epi, class Sched, bool ALIGN_EPI = true, bool SP2 = true>
__device__ __forceinline__ void gemm_phase(LAS unsigned char* lds, const Gemm g, const Sched& S, const Epi& E) {
    const int tid = threadIdx.x, wid = __builtin_amdgcn_readfirstlane(tid >> 6), lane = tid & 63, wr = wid >> 2, wc = wid & 3, fr = lane & 15, fq = lane >> 4;
    const int K = g.K, nt = K / BK, lda = g.lda;
    unsigned voffA[2], voffB[2];
#pragma unroll
    for (int i = 0; i < 2; ++i) { int R, C; stage_rc(tid * 16 + i * 8192, R, C); const int Rb = Epi::PERM ? ((R & ~31) + perm32(R & 31)) : R;
        voffA[i] = (unsigned)(R * lda + C) * 2u; voffB[i] = (unsigned)(Rb * K + C) * 2u; }
    const size_t kstep = (size_t)(BK * 2);
    const size_t hstepA = (size_t)HALF * lda * 2, hstepB = (size_t)HALF * K * 2;
    const size_t tstepA = 2 * hstepA, tstepB = 2 * hstepB;
    const unsigned ldsw = (unsigned)wid * 1024u;
    const int aoff = lds_byte(wr * 64 + fr, fq * 8), boff = lds_byte(wc * 32 + fr, fq * 8);
#define PG8_SA(b, h) (((b) * 2 + (h)) * HTB)
#define PG8_SB(b, h) ((4 + (b) * 2 + (h)) * HTB)
#define PG8_STAGE(bufoff, gbase, voff) do { _Pragma("unroll") for (int _i = 0; _i < 2; ++_i) \
        __builtin_amdgcn_global_load_lds((const unsigned*)((const char*)(gbase) + (voff)[_i]), (LAS unsigned*)(lds + (bufoff) + ldsw + _i * 8192), 16, 0, 0); } while (0)
#define PG8_LDA(dst, b, h) do { _Pragma("unroll") for (int m = 0; m < 4; ++m) _Pragma("unroll") for (int k = 0; k < 2; ++k) dst[m][k] = *(const LAS bf16x8*)(lds + PG8_SA(b, h) + aoff + m * 2048 + k * 1024); } while (0)
#define PG8_LDB(dst, b, h) do { _Pragma("unroll") for (int n = 0; n < 2; ++n) _Pragma("unroll") for (int k = 0; k < 2; ++k) dst[n][k] = *(const LAS bf16x8*)(lds + PG8_SB(b, h) + boff + n * 2048 + k * 1024); } while (0)
#define PG8_MMA(ai, bj, At, Bt) do { __builtin_amdgcn_s_setprio(1); _Pragma("unroll") for (int m = 0; m < 4; ++m) _Pragma("unroll") for (int n = 0; n < 2; ++n) _Pragma("unroll") for (int k = 0; k < 2; ++k) \
        acc[ai][bj][m][n] = __builtin_amdgcn_mfma_f32_16x16x32_bf16(Bt[n][k], At[m][k], acc[ai][bj][m][n], 0, 0, 0); __builtin_amdgcn_s_setprio(0); } while (0)
#define PG8_WAIT_V(n) asm volatile("s_waitcnt vmcnt(" #n ")" ::: "memory")
#define PG8_WAIT_L(n) asm volatile("s_waitcnt lgkmcnt(" #n ")" ::: "memory")
#define PG8_BAR __builtin_amdgcn_s_barrier()
#define PG8_SCHED __builtin_amdgcn_sched_barrier(0)
    Unit cur, nxt; int ui = 0;
    if (!S.next(0, cur)) return;
    f32x4 acc[2][2][4][2];
#pragma unroll
    for (int a = 0; a < 2; ++a)
#pragma unroll
        for (int b = 0; b < 2; ++b)
#pragma unroll
            for (int m = 0; m < 4; ++m)
#pragma unroll
                for (int n = 0; n < 2; ++n) acc[a][b][m][n] = (f32x4){0.f, 0.f, 0.f, 0.f};
    bf16x8 At[4][2], B0[2][2], B1[2][2];
    const char* cA = (const char*)(g.A + (size_t)cur.b * g.bsA) + (size_t)cur.pm * tstepA;
    const char* cB = (const char*)(g.Bt + (size_t)cur.b * g.bsB) + (size_t)cur.pn * tstepB;
    if constexpr (SP2) {
        PG8_STAGE(PG8_SB(0, 0), cB, voffB); PG8_STAGE(PG8_SB(0, 1), cB + hstepB, voffB); PG8_STAGE(PG8_SA(0, 0), cA, voffA); PG8_STAGE(PG8_SA(0, 1), cA + hstepA, voffA);
        if (wr == 1) PG8_BAR;
        PG8_WAIT_V(2); PG8_BAR;
        PG8_STAGE(PG8_SB(1, 0), cB + kstep, voffB); PG8_STAGE(PG8_SA(1, 0), cA + kstep, voffA); PG8_STAGE(PG8_SB(1, 1), cB + hstepB + kstep, voffB);
        PG8_WAIT_V(6); PG8_BAR;
    } else {
        PG8_STAGE(PG8_SB(0, 0), cB, voffB); PG8_STAGE(PG8_SA(0, 0), cA, voffA); PG8_STAGE(PG8_SB(0, 1), cB + hstepB, voffB); PG8_STAGE(PG8_SA(0, 1), cA + hstepA, voffA);
        if (wr == 1) PG8_BAR;
        PG8_WAIT_V(4); PG8_BAR;
        PG8_STAGE(PG8_SB(1, 0), cB + kstep, voffB); PG8_STAGE(PG8_SA(1, 0), cA + kstep, voffA); PG8_STAGE(PG8_SB(1, 1), cB + hstepB + kstep, voffB);
        PG8_WAIT_V(6); PG8_BAR;
    }
    for (;;) {
        const bool has_next = S.next(ui + 1, nxt);
        const char* nA = has_next ? (const char*)(g.A + (size_t)nxt.b * g.bsA) + (size_t)nxt.pm * tstepA : cA;
        const char* nB = has_next ? (const char*)(g.Bt + (size_t)nxt.b * g.bsB) + (size_t)nxt.pn * tstepB : cB;
        for (int t = 0; t < nt; t += 2) {
            const bool last = (t == nt - 2);
            const char* a1 = cA + (size_t)(t + 1) * kstep;
            const char* a2 = last ? nA : cA + (size_t)(t + 2) * kstep; const char* b2 = last ? nB : cB + (size_t)(t + 2) * kstep;
            const char* a3 = a2 + kstep; const char* b3 = b2 + kstep;
            if constexpr (SP2) {
            PG8_LDB(B0, 0, 0); PG8_LDB(B1, 0, 1); PG8_SCHED; PG8_LDA(At, 0, 0); PG8_STAGE(PG8_SA(1, 1), a1 + hstepA, voffA);
            PG8_WAIT_V(8); PG8_WAIT_L(0); PG8_BAR; PG8_MMA(0, 0, At, B0); PG8_MMA(0, 1, At, B1); PG8_BAR; PG8_SCHED;
            PG8_LDA(At, 0, 1); PG8_STAGE(PG8_SB(0, 0), b2, voffB); PG8_STAGE(PG8_SB(0, 1), b2 + hstepB, voffB); PG8_STAGE(PG8_SA(0, 0), a2, voffA);
            PG8_WAIT_V(8); PG8_WAIT_L(0); PG8_BAR; PG8_MMA(1, 0, At, B0); PG8_MMA(1, 1, At, B1); PG8_BAR; PG8_SCHED;
            PG8_LDB(B0, 1, 0); PG8_LDB(B1, 1, 1); PG8_SCHED; PG8_LDA(At, 1, 0); PG8_STAGE(PG8_SA(0, 1), a2 + hstepA, voffA);
            PG8_WAIT_V(8); PG8_WAIT_L(0); PG8_BAR; PG8_MMA(0, 0, At, B0); PG8_MMA(0, 1, At, B1); PG8_BAR; PG8_SCHED;
            PG8_LDA(At, 1, 1); PG8_STAGE(PG8_SB(1, 0), b3, voffB); PG8_STAGE(PG8_SB(1, 1), b3 + hstepB, voffB); PG8_STAGE(PG8_SA(1, 0), a3, voffA);
            PG8_WAIT_V(8); PG8_WAIT_L(0); PG8_BAR; PG8_MMA(1, 0, At, B0); PG8_MMA(1, 1, At, B1); PG8_BAR; PG8_SCHED;
            } else {
            PG8_LDB(B0, 0, 0); PG8_SCHED; PG8_LDA(At, 0, 0); PG8_STAGE(PG8_SA(1, 1), a1 + hstepA, voffA);
            PG8_WAIT_L(8); PG8_BAR; PG8_WAIT_L(0); PG8_MMA(0, 0, At, B0); PG8_BAR; PG8_SCHED;
            PG8_LDB(B1, 0, 1); PG8_STAGE(PG8_SB(0, 0), b2, voffB);
            PG8_BAR; PG8_WAIT_L(0); PG8_MMA(0, 1, At, B1); PG8_BAR;
            PG8_LDA(At, 0, 1); PG8_STAGE(PG8_SA(0, 0), a2, voffA);
            PG8_BAR; PG8_WAIT_L(0); PG8_MMA(1, 0, At, B0); PG8_BAR; PG8_SCHED;
            PG8_STAGE(PG8_SB(0, 1), b2 + hstepB, voffB);
            PG8_WAIT_V(6); PG8_BAR; PG8_MMA(1, 1, At, B1); PG8_BAR;
            PG8_LDB(B0, 1, 0); PG8_SCHED; PG8_LDA(At, 1, 0); PG8_STAGE(PG8_SA(0, 1), a2 + hstepA, voffA);
            PG8_WAIT_L(8); PG8_BAR; PG8_WAIT_L(0); PG8_MMA(0, 0, At, B0); PG8_BAR; PG8_SCHED;
            PG8_LDB(B1, 1, 1); PG8_STAGE(PG8_SB(1, 0), b3, voffB);
            PG8_BAR; PG8_WAIT_L(0); PG8_MMA(0, 1, At, B1); PG8_BAR;
            PG8_LDA(At, 1, 1); PG8_STAGE(PG8_SA(1, 0), a3, voffA);
            PG8_BAR; PG8_WAIT_L(0); PG8_MMA(1, 0, At, B0); PG8_BAR; PG8_SCHED;
            PG8_STAGE(PG8_SB(1, 1), b3 + hstepB, voffB);
            PG8_WAIT_V(6); PG8_BAR; PG8_MMA(1, 1, At, B1); PG8_BAR;
            }
        }
        if constexpr (ALIGN_EPI) { if (wr == 0) PG8_BAR; }
        E(acc, cur, wr, wc, fr, fq);
        if (!has_next) break;
#pragma unroll
        for (int a = 0; a < 2; ++a)
#pragma unroll
            for (int b = 0; b < 2; ++b)
#pragma unroll
                for (int m = 0; m < 4; ++m)
#pragma unroll
                    for (int n = 0; n < 2; ++n) acc[a][b][m][n] = (f32x4){0.f, 0.f, 0.f, 0.f};
        cur = nxt; cA = nA; cB = nB; ++ui;
        if constexpr (ALIGN_EPI) { if (wr == 1) PG8_BAR; }
    }
    PG8_WAIT_V(0);
    if constexpr (!ALIGN_EPI) { if (wr == 0) PG8_BAR; }
    PG8_BAR;
#undef PG8_SA
#undef PG8_SB
#undef PG8_STAGE
#undef PG8_LDA
#undef PG8_LDB
#undef PG8_MMA
#undef PG8_WAIT_V
#undef PG8_WAIT_L
#undef PG8_BAR
#undef PG8_SCHED
}

__device__ __forceinline__ u32x4 pack8(const f32x4 v0, const f32x4 v1) { u32x4 w; w.x = cvt_pk_bf16(v0[0], v0[1]); w.y = cvt_pk_bf16(v0[2], v0[3]); w.z = cvt_pk_bf16(v1[0], v1[1]); w.w = cvt_pk_bf16(v1[2], v1[3]); return w; }
__device__ __forceinline__ void unpack8(const u32x4 w, f32x4& v0, f32x4& v1) { v0 = (f32x4){bflo(w.x), bfhi(w.x), bflo(w.y), bfhi(w.y)}; v1 = (f32x4){bflo(w.z), bfhi(w.z), bflo(w.w), bfhi(w.w)}; }

struct EpiF32 {
    static constexpr bool PERM = false;
    float* C; int ldc; int boff;
    __device__ __forceinline__ void operator()(const f32x4 (&acc)[2][2][4][2], const Unit& u, int wr, int wc, int fr, int fq) const {
        const int row0 = u.pm * BM + wr * 64 + fr, col0 = u.pn * BM + wc * 32 + 4 * fq + u.b * boff;
#pragma unroll
        for (int ai = 0; ai < 2; ++ai)
#pragma unroll
            for (int m = 0; m < 4; ++m) { float* rowp = C + (size_t)(row0 + ai * HALF + m * 16) * ldc + col0;
#pragma unroll
                for (int bj = 0; bj < 2; ++bj)
#pragma unroll
                    for (int n = 0; n < 2; ++n) *(f32x4*)(rowp + bj * HALF + n * 16) = acc[ai][bj][m][n]; }
    }
};
struct EpiZ {
    static constexpr bool PERM = true;
    bf16_t* z3; bf16_t* U;
    __device__ __forceinline__ void operator()(const f32x4 (&acc)[2][2][4][2], const Unit& u, int wr, int wc, int fr, int fq) const {
        const int row0 = u.pm * BM + wr * 64 + fr;
#pragma unroll
        for (int ai = 0; ai < 2; ++ai)
#pragma unroll
            for (int m = 0; m < 4; ++m) { const int row = row0 + ai * HALF + m * 16;
#pragma unroll
                for (int bj = 0; bj < 2; ++bj) { const int c0 = u.pn * BM + bj * HALF + wc * 32 + 8 * fq;
                    const u32x4 w = pack8(acc[ai][bj][m][0], acc[ai][bj][m][1]);
                    if (u.pn < 6) *(u32x4*)(z3 + (size_t)row * DZ3 + c0) = w;
                    else { const int cz = c0 - DZ3; *(u32x4*)(U + (size_t)(row >> 6) * UROW + (cz >> 4) * TPK + (row & 63) * 16 + (cz & 15)) = w; } } }
    }
};
struct EpiT {
    static constexpr bool PERM = true;
    const bf16_t* U; const float* dsk; bf16_t* yg;
    __device__ __forceinline__ void operator()(const f32x4 (&acc)[2][2][4][2], const Unit& u, int wr, int wc, int fr, int fq) const {
        const int row0 = u.pm * BM + wr * 64 + fr, g = u.b;
#pragma unroll
        for (int bj = 0; bj < 2; ++bj) { const int c0 = u.pn * BM + bj * HALF + wc * 32 + 8 * fq; const int i = c0 >> 4, h0 = c0 & 15, ch = g * 16 + h0;
            const f32x4 d0 = *(const f32x4*)(dsk + ch), d1 = *(const f32x4*)(dsk + ch + 4);
#pragma unroll
            for (int ai = 0; ai < 2; ++ai)
#pragma unroll
                for (int m = 0; m < 4; ++m) { const int row = row0 + ai * HALF + m * 16;
                    const u32x4 uw = *(const u32x4*)(U + (size_t)row * UROW + g * TPK + c0); f32x4 u0, u1; unpack8(uw, u0, u1);
                    f32x4 v0 = acc[ai][bj][m][0] + d0 * u0, v1 = acc[ai][bj][m][1] + d1 * u1;
#pragma unroll
                    for (int j = 0; j < 4; ++j) { v0[j] = gelu_tanh(v0[j]); v1[j] = gelu_tanh(v1[j]); }
                    *(u32x4*)(yg + (size_t)(row * 64 + i) * 512 + ch) = pack8(v0, v1); } }
    }
};
struct EpiGlu {
    static constexpr bool PERM = true;
    const bf16_t* yg; const float* bias; bf16_t* ys;
    __device__ __forceinline__ void operator()(const f32x4 (&acc)[2][2][4][2], const Unit& u, int wr, int wc, int fr, int fq) const {
        const int row0 = u.pm * BM + wr * 64 + fr;
#pragma unroll
        for (int bj = 0; bj < 2; ++bj) { const int c0 = u.pn * BM + bj * HALF + wc * 32 + 8 * fq;
            const f32x4 b0 = *(const f32x4*)(bias + c0), b1 = *(const f32x4*)(bias + c0 + 4);
#pragma unroll
            for (int ai = 0; ai < 2; ++ai)
#pragma unroll
                for (int m = 0; m < 4; ++m) { const int row = row0 + ai * HALF + m * 16;
                    const u32x4 yw = *(const u32x4*)(yg + (size_t)row * 512 + c0); f32x4 y0, y1; unpack8(yw, y0, y1);
                    f32x4 v0 = acc[ai][bj][m][0] + b0, v1 = acc[ai][bj][m][1] + b1;
#pragma unroll
                    for (int j = 0; j < 4; ++j) { v0[j] = y0[j] * sigmoidf_(v0[j]); v1[j] = y1[j] * sigmoidf_(v1[j]); }
                    *(u32x4*)(ys + (size_t)row * 512 + c0) = pack8(v0, v1); } }
    }
};
__device__ __forceinline__ f32x4 shfl4(const f32x4 v, int src) { f32x4 r; r[0] = __shfl(v[0], src); r[1] = __shfl(v[1], src); r[2] = __shfl(v[2], src); r[3] = __shfl(v[3], src); return r; }
struct EpiAct {
    static constexpr bool PERM = true;
    bf16_t* act; float* edge; const float* cw; const float* cb; LAS float* xb;
    __device__ __forceinline__ void operator()(const f32x4 (&acc)[2][2][4][2], const Unit& u, int wr, int wc, int fr, int fq) const {
        const int lane = threadIdx.x & 63;
        const int lc0 = 32 * wc + 8 * fq;
#pragma unroll
        for (int ai = 0; ai < 2; ++ai)
#pragma unroll
            for (int bj = 0; bj < 2; ++bj)
#pragma unroll
                for (int n = 0; n < 2; ++n) {
                    if (fr == 0) *(LAS f32x4*)(xb + ((2 * ai + wr) * 2 + 0) * 256 + 128 * bj + lc0 + 4 * n) = acc[ai][bj][0][n];
                    if (fr == 15) *(LAS f32x4*)(xb + ((2 * ai + wr) * 2 + 1) * 256 + 128 * bj + lc0 + 4 * n) = acc[ai][bj][3][n];
                }
        if (wr == 0 && fr < 2) {
#pragma unroll
            for (int bj = 0; bj < 2; ++bj)
#pragma unroll
                for (int n = 0; n < 2; ++n) *(f32x4*)(edge + (size_t)(u.pm * 4 + fr) * DUP + u.pn * 256 + 128 * bj + lc0 + 4 * n) = acc[0][bj][0][n];
        }
        if (wr == 1 && fr >= 14) {
#pragma unroll
            for (int bj = 0; bj < 2; ++bj)
#pragma unroll
                for (int n = 0; n < 2; ++n) *(f32x4*)(edge + (size_t)(u.pm * 4 + 2 + (fr - 14)) * DUP + u.pn * 256 + 128 * bj + lc0 + 4 * n) = acc[1][bj][3][n];
        }
        asm volatile("s_waitcnt lgkmcnt(0)" ::: "memory"); __builtin_amdgcn_s_barrier(); asm volatile("" ::: "memory");
        const int sprev = (lane & 48) | ((lane - 1) & 15), snext = (lane & 48) | ((lane + 1) & 15);
        const int ch0 = 128 * u.pn + lc0;
#pragma unroll
        for (int n = 0; n < 2; ++n) {
            const int ch = ch0 + 4 * n;
            f32x4 w0[2], w1[2], w2[2], bb[2];
#pragma unroll
            for (int bj = 0; bj < 2; ++bj) { const int col = ch + bj * DFF;
                w0[bj] = *(const f32x4*)(cw + col); w1[bj] = *(const f32x4*)(cw + DUP + col); w2[bj] = *(const f32x4*)(cw + 2 * DUP + col); bb[bj] = *(const f32x4*)(cb + col); }
#pragma unroll
            for (int ai = 0; ai < 2; ++ai) {
                const int q = 2 * ai + wr;
#pragma unroll
                for (int m = 0; m < 4; ++m) {
                    f32x4 cv[2];
#pragma unroll
                    for (int bj = 0; bj < 2; ++bj) {
                        const f32x4 cur = acc[ai][bj][m][n];
                        f32x4 tp = cur, tn = cur;
                        if (m > 0) { const f32x4 o = acc[ai][bj][m > 0 ? m - 1 : 0][n]; tp = (fr == 15) ? o : cur; }
                        if (m < 3) { const f32x4 o = acc[ai][bj][m < 3 ? m + 1 : 3][n]; tn = (fr == 0) ? o : cur; }
                        f32x4 prev = shfl4(tp, sprev), next = shfl4(tn, snext);
                        if (m == 0) { f32x4 top = (f32x4){0.f, 0.f, 0.f, 0.f}; if (q > 0) top = *(const LAS f32x4*)(xb + ((q - 1) * 2 + 1) * 256 + 128 * bj + lc0 + 4 * n); prev = (fr == 0) ? top : prev; }
                        if (m == 3) { f32x4 bot = (f32x4){0.f, 0.f, 0.f, 0.f}; if (q < 3) bot = *(const LAS f32x4*)(xb + ((q + 1) * 2 + 0) * 256 + 128 * bj + lc0 + 4 * n); next = (fr == 15) ? bot : next; }
                        cv[bj] = w0[bj] * prev + w1[bj] * cur + w2[bj] * next + bb[bj];
                    }
                    f32x4 a;
#pragma unroll
                    for (int j = 0; j < 4; ++j) a[j] = cv[0][j] * sigmoidf_(cv[0][j]) * cv[1][j];
                    u32x2 w; w.x = cvt_pk_bf16(a[0], a[1]); w.y = cvt_pk_bf16(a[2], a[3]);
                    const int row = u.pm * BM + ai * HALF + wr * 64 + m * 16 + fr;
                    *(u32x2*)(act + (size_t)row * DFF + ch) = w;
                }
            }
        }
    }
};
}

struct Params { const float* in[25]; float* out; unsigned char* ws; };

__device__ __forceinline__ void transpose_item(const float* W, int K, int N, bf16_t* WT, int drow0, const float* gain, LAS float* scr, int k0, int n0, int lane) {
#pragma unroll 8
    for (int i = 0; i < 32; ++i) { const int kk = 2 * i + (lane >> 5); float w = W[(size_t)(k0 + kk) * N + n0 + (lane & 31)]; if (gain) w *= gain[k0 + kk]; scr[kk * 33 + (lane & 31)] = w; }
    asm volatile("s_waitcnt lgkmcnt(0)" ::: "memory");
    const int c = lane & 7;
#pragma unroll
    for (int j = 0; j < 4; ++j) { const int n = (lane >> 3) + 8 * j; const LAS float* s = scr + (8 * c) * 33 + n;
        u32x4 o; o.x = pk2(s[0 * 33], s[1 * 33]); o.y = pk2(s[2 * 33], s[3 * 33]); o.z = pk2(s[4 * 33], s[5 * 33]); o.w = pk2(s[6 * 33], s[7 * 33]);
        *(u32x4*)(WT + (size_t)(drow0 + n) * K + k0 + 8 * c) = o; }
    asm volatile("s_waitcnt lgkmcnt(0)" ::: "memory");
}

__global__ void __launch_bounds__(512, 2) mk_fwd(Params p) {
    extern __shared__ __attribute__((aligned(16))) unsigned char lds_raw[];
    LAS unsigned char* lds = (LAS unsigned char*)lds_raw;
    cg::grid_group grid = cg::this_grid();
    const int tid = threadIdx.x, lane = tid & 63, wave = __builtin_amdgcn_readfirstlane(tid >> 6);
    const int G = gridDim.x, bx = blockIdx.x;
    const int gw = bx * 8 + wave, NGW = G * 8;
    const int gt = bx * 512 + tid, NGT = G * 512;
    unsigned char* ws = p.ws;
    const float* xp = p.in[0]; const float* xs = p.in[1];
    bf16_t* Win = (bf16_t*)(ws + WS_WIN); bf16_t* Wglu = (bf16_t*)(ws + WS_WGLU); bf16_t* Wout = (bf16_t*)(ws + WS_WOUT); bf16_t* Wup = (bf16_t*)(ws + WS_WUP); bf16_t* Wdn = (bf16_t*)(ws + WS_WDN);
    f32x2* POW = (f32x2*)(ws + WS_POW); f32x2* BBAR = (f32x2*)(ws + WS_BBAR); float* KT = (float*)(ws + WS_KT); bf16_t* BIN = (bf16_t*)(ws + WS_BIN); bf16_t* TP = (bf16_t*)(ws + WS_TP);
    bf16_t* Hb = (bf16_t*)(ws + WS_H); bf16_t* Z3 = (bf16_t*)(ws + WS_Z3); bf16_t* Ub = (bf16_t*)(ws + WS_U); float* ELOC = (float*)(ws + WS_ELOC);
    bf16_t* YG = (bf16_t*)(ws + WS_YG); bf16_t* YS = (bf16_t*)(ws + WS_YS); bf16_t* YCAT = (bf16_t*)(ws + WS_YCAT); float* Yf = (float*)(ws + WS_Y);
    bf16_t* H2 = (bf16_t*)(ws + WS_H2); bf16_t* ACT = (bf16_t*)(ws + WS_ACT); float* EDGE = (float*)(ws + WS_EDGE); float* Ff = (float*)(ws + WS_F);
    float* OUT = p.out;

    {
        LAS float* scr = (LAS float*)(lds + wave * 16384);
        constexpr int I_IN = 16 * 64, I_GLU = 8 * 16, I_OUT = 16 * 32, I_UP = 16 * 176, I_DN = 44 * 32, NITEMS = I_IN + I_GLU + I_OUT + I_UP + I_DN;
        for (int it = gw; it < NITEMS; it += NGW) {
            int r = it;
            if (r < I_IN) { const int kb = r / 64, nb = r % 64; transpose_item(p.in[3], 1024, 2048, Win, nb * 32, p.in[2], scr, kb * 64, nb * 32, lane); continue; } r -= I_IN;
            if (r < I_GLU) { const int kb = r / 16, nb = r % 16; transpose_item(p.in[13], 512, 512, Wglu, nb * 32, nullptr, scr, kb * 64, nb * 32, lane); continue; } r -= I_GLU;
            if (r < I_OUT) { const int kb = r / 32, nb = r % 32; const float* gn = (kb < 8) ? p.in[15] : (p.in[16] - 512); transpose_item(p.in[17], 1024, 1024, Wout, nb * 32, gn, scr, kb * 64, nb * 32, lane); continue; } r -= I_OUT;
            if (r < I_UP) { const int kb = r / 176, nb = r % 176; const int n0 = nb * 32; const int ch0 = n0 < DFF ? n0 : n0 - DFF; const int drow0 = (ch0 >> 7) * 256 + (ch0 & 127) + (n0 < DFF ? 0 : 128);
                transpose_item(p.in[20], 1024, DUP, Wup, drow0, p.in[19], scr, kb * 64, n0, lane); continue; } r -= I_UP;
            { const int kb = r / 32, nb = r % 32; transpose_item(p.in[23], DFF, 1024, Wdn, nb * 32, nullptr, scr, kb * 64, nb * 32, lane); }
        }
        for (int m = gw; m < NTOK; m += NGW) {
            const float* xrow = (m < NPROMPT) ? xp + (size_t)m * DM : xs + (size_t)(m - NPROMPT) * DM;
            f32x4 v[4]; float s = 0.f;
#pragma unroll
            for (int j = 0; j < 4; ++j) { v[j] = ((const f32x4*)xrow)[lane + 64 * j]; s += (v[j].x * v[j].x + v[j].y * v[j].y) + (v[j].z * v[j].z + v[j].w * v[j].w); }
            const float rstd = rsqrtf(wave_sum(s) * (1.f / DM) + EPS);
            u32x2* o = (u32x2*)(Hb + (size_t)m * DM);
#pragma unroll
            for (int j = 0; j < 4; ++j) { u32x2 w; w.x = pk2(v[j].x * rstd, v[j].y * rstd); w.y = pk2(v[j].z * rstd, v[j].w * rstd); o[lane + 64 * j] = w; }
        }
        for (int idx = gt; idx < 4096; idx += NGT) {
            const float lr = p.in[5][idx], li = p.in[6][idx], dt = expf(p.in[7][idx >> 6]);
            const float e = expf(lr * dt), th = li * dt; const float lbr = e * cosf(th), lbi = e * sinf(th);
            const float den = 1.0f / (lr * lr + li * li); const float ar = lbr - 1.0f;
            const float cr = (ar * lr + lbi * li) * den, ci = (lbi * lr - ar * li) * den;
            for (int h = 0; h < 16; ++h) { const float br = p.in[8][idx * 16 + h], bi = p.in[9][idx * 16 + h]; BBAR[idx * 16 + h] = (f32x2){cr * br - ci * bi, cr * bi + ci * br}; }
            float pr = 1.f, pi = 0.f;
            for (int k = 0; k <= 64; ++k) { POW[idx * 65 + k] = (f32x2){pr, pi}; const float nr = pr * lbr - pi * lbi, ni = pr * lbi + pi * lbr; pr = nr; pi = ni; }
        }
    }
    grid.sync();

    {
        for (int e = gt; e < 2 * 32 * 64 * 256; e += NGT) {
            const int hp = e & 15, h = (e >> 4) & 15, d = (e >> 8) & 63, dg = e >> 14;
            const float* cre = p.in[10] + dg * 1024 + h * 64; const float* cim = p.in[11] + dg * 1024 + h * 64;
            float s = 0.f;
            for (int pp = 0; pp < 64; ++pp) { const int idx = dg * 64 + pp; const f32x2 pw = POW[idx * 65 + d], bb = BBAR[idx * 16 + hp]; const float cr = cre[pp], ci = cim[pp];
                s += (cr * pw.x - ci * pw.y) * bb.x - (cr * pw.y + ci * pw.x) * bb.y; }
            KT[e] = s;
        }
        for (int e = gt; e < 32 * 256 * 128; e += NGT) {
            const int k0 = (e & 127) * 8, n = (e >> 7) & 255, g = e >> 15; const int j = k0 >> 4, h0 = k0 & 15, pp = n & 63, dir = n >> 7;
            const int idx = (dir * 32 + g) * 64 + pp; const f32x2 pw = POW[idx * 65 + (dir ? j : 63 - j)]; const bool im = (n >> 6) & 1;
            float v[8];
#pragma unroll
            for (int q = 0; q < 8; ++q) { const f32x2 bb = BBAR[idx * 16 + h0 + q]; v[q] = im ? (pw.x * bb.y + pw.y * bb.x) : (pw.x * bb.x - pw.y * bb.y); }
            u32x4 o; o.x = pk2(v[0], v[1]); o.y = pk2(v[2], v[3]); o.z = pk2(v[4], v[5]); o.w = pk2(v[6], v[7]);
            *(u32x4*)(BIN + (size_t)(g * 256 + n) * 1024 + k0) = o;
        }
        for (int e = gt; e < 32 * 1024 * 32; e += NGT) {
            const int q0 = (e & 31) * 8, n = (e >> 5) & 1023, g = e >> 15; const int i = n >> 4, h = n & 15, blk = q0 >> 6, dir = blk >> 1; const bool im = blk & 1;
            float v[8];
#pragma unroll
            for (int q = 0; q < 8; ++q) { const int pp = (q0 + q) & 63; const int idx = (dir * 32 + g) * 64 + pp; const f32x2 pw = POW[idx * 65 + (dir ? 64 - i : i + 1)];
                const float cr = p.in[10][(dir * 32 + g) * 1024 + h * 64 + pp], ci = p.in[11][(dir * 32 + g) * 1024 + h * 64 + pp];
                v[q] = im ? -(cr * pw.y + ci * pw.x) : (cr * pw.x - ci * pw.y); }
            u32x4 o; o.x = pk2(v[0], v[1]); o.y = pk2(v[2], v[3]); o.z = pk2(v[4], v[5]); o.w = pk2(v[6], v[7]);
            *(u32x4*)(TP + (size_t)(g * 1024 + n) * TPK + 1024 + q0) = o;
        }
        pg8::Gemm g{Hb, Win, 1024, 1024, 0, 0}; pg8::StaticOrder S; S.init(NTOK, 2048, G, bx);
        pg8::EpiZ E{Z3, Ub};
        pg8::gemm_phase<pg8::EpiZ, pg8::StaticOrder>(lds, g, S, E);
    }
    grid.sync();

    {
        for (int e = gt; e < 32 * 1024 * 128; e += NGT) {
            const int k0 = (e & 127) * 8, n = (e >> 7) & 1023, g = e >> 17; const int i = n >> 4, h = n & 15, j = k0 >> 4, h0 = k0 & 15;
            f32x4 a, b;
            if (i > j) { const float* s = KT + ((size_t)((0 * 32 + g) * 64 + (i - j)) * 256 + h * 16 + h0); a = *(const f32x4*)s; b = *(const f32x4*)(s + 4); }
            else if (i < j) { const float* s = KT + ((size_t)((1 * 32 + g) * 64 + (j - i)) * 256 + h * 16 + h0); a = *(const f32x4*)s; b = *(const f32x4*)(s + 4); }
            else { const float* s = KT + ((size_t)((0 * 32 + g) * 64) * 256 + h * 16 + h0); const float* s2 = KT + ((size_t)((1 * 32 + g) * 64) * 256 + h * 16 + h0);
                a = *(const f32x4*)s + *(const f32x4*)s2; b = *(const f32x4*)(s + 4) + *(const f32x4*)(s2 + 4); }
            u32x4 o; o.x = pk2(a.x, a.y); o.y = pk2(a.z, a.w); o.z = pk2(b.x, b.y); o.w = pk2(b.z, b.w);
            *(u32x4*)(TP + (size_t)(g * 1024 + n) * TPK + k0) = o;
        }
        pg8::Gemm g{Ub, BIN, UROW, 1024, (size_t)TPK, (size_t)256 * 1024}; pg8::BatchOrder S; S.init(NCHUNK / 256, 1, 32, G, bx);
        pg8::EpiF32 E{ELOC, 32 * 256, 256};
        pg8::gemm_phase<pg8::EpiF32, pg8::BatchOrder>(lds, g, S, E);
    }
    grid.sync();

    {
        for (int id = gt; id < 32 * 32 * 2 * 64; id += NGT) {
            const int pp = id & 63, dir = (id >> 6) & 1, g = (id >> 7) & 31, seq = id >> 12;
            const int cb = seq < 16 ? seq * 32 : 512 + (seq - 16) * 64, nc = seq < 16 ? 32 : 64;
            const f32x2 lt = POW[((dir * 32 + g) * 64 + pp) * 65 + 64];
            float sr = 0.f, si = 0.f;
            for (int c8 = 0; c8 < nc; c8 += 8) {
                float er[8], ei[8];
#pragma unroll
                for (int q = 0; q < 8; ++q) { const int c = dir ? (nc - 1 - (c8 + q)) : (c8 + q); const float* ep = ELOC + ((size_t)(cb + c) * 32 + g) * 256 + dir * 128 + pp; er[q] = ep[0]; ei[q] = ep[64]; }
#pragma unroll
                for (int q = 0; q < 8; ++q) { const int c = dir ? (nc - 1 - (c8 + q)) : (c8 + q); bf16_t* up = Ub + (size_t)(cb + c) * UROW + g * TPK + 1024 + dir * 128 + pp;
                    up[0] = (bf16_t)f2bf(sr); up[64] = (bf16_t)f2bf(si);
                    const float nr = lt.x * sr - lt.y * si + er[q], ni = lt.x * si + lt.y * sr + ei[q]; sr = nr; si = ni; }
            }
        }
    }
    grid.sync();

    {
        pg8::Gemm g{Ub, TP, UROW, TPK, (size_t)TPK, (size_t)1024 * TPK}; pg8::BatchOrder S; S.init(NCHUNK / 256, 4, 32, G, bx);
        pg8::EpiT E{Ub, p.in[12], YG};
        pg8::gemm_phase<pg8::EpiT, pg8::BatchOrder>(lds, g, S, E);
    }
    grid.sync();

    {
        pg8::Gemm g{YG, Wglu, 512, 512, 0, 0}; pg8::StaticOrder S; S.init(NTOK, 512, G, bx);
        pg8::EpiGlu E{YG, p.in[14], YS};
        pg8::gemm_phase<pg8::EpiGlu, pg8::StaticOrder>(lds, g, S, E);
    }
    grid.sync();

    {
        const int c = 8 * lane;
        const float* cw = p.in[4];
        f32x4 w0a = *(const f32x4*)(cw + c), w0b = *(const f32x4*)(cw + c + 4), w1a = *(const f32x4*)(cw + 512 + c), w1b = *(const f32x4*)(cw + 512 + c + 4), w2a = *(const f32x4*)(cw + 1024 + c), w2b = *(const f32x4*)(cw + 1024 + c + 4);
        for (int m = gw; m < NTOK; m += NGW) {
            int t, L; seqpos(m, t, L);
            const bf16_t* zr = Z3 + (size_t)m * DZ3;
            const u32x4 zero = (u32x4){0u, 0u, 0u, 0u};
            const u32x4 zbw = *(const u32x4*)(zr + c), zc0 = *(const u32x4*)(zr + 512 + c), zx0 = *(const u32x4*)(zr + 1024 + c);
            u32x4 zcm = zero, zxm = zero, zcp = zero, zxp = zero;
            if (t > 0) { zcm = *(const u32x4*)(zr - DZ3 + 512 + c); zxm = *(const u32x4*)(zr - DZ3 + 1024 + c); }
            if (t < L - 1) { zcp = *(const u32x4*)(zr + DZ3 + 512 + c); zxp = *(const u32x4*)(zr + DZ3 + 1024 + c); }
            const u32x4 ysw = *(const u32x4*)(YS + (size_t)m * 512 + c);
            f32x4 b0, b1, a0, a1, x0, x1, am0, am1, xm0, xm1, ap0, ap1, xp0, xp1;
            pg8::unpack8(zbw, b0, b1); pg8::unpack8(zc0, a0, a1); pg8::unpack8(zx0, x0, x1); pg8::unpack8(zcm, am0, am1); pg8::unpack8(zxm, xm0, xm1); pg8::unpack8(zcp, ap0, ap1); pg8::unpack8(zxp, xp0, xp1);
            f32x4 y0 = b0 * (w0a * (am0 * xm0) + w1a * (a0 * x0) + w2a * (ap0 * xp0));
            f32x4 y1 = b1 * (w0b * (am1 * xm1) + w1b * (a1 * x1) + w2b * (ap1 * xp1));
            float ss = (y0.x * y0.x + y0.y * y0.y) + (y0.z * y0.z + y0.w * y0.w) + (y1.x * y1.x + y1.y * y1.y) + (y1.z * y1.z + y1.w * y1.w);
            const float rc = rsqrtf(wave_sum(ss) * (1.f / 512.f) + EPS);
            *(u32x4*)(YCAT + (size_t)m * DM + c) = pg8::pack8(y0 * rc, y1 * rc);
            f32x4 s0, s1; pg8::unpack8(ysw, s0, s1);
            float s2 = (s0.x * s0.x + s0.y * s0.y) + (s0.z * s0.z + s0.w * s0.w) + (s1.x * s1.x + s1.y * s1.y) + (s1.z * s1.z + s1.w * s1.w);
            const float rs = rsqrtf(wave_sum(s2) * (1.f / 512.f) + EPS);
            *(u32x4*)(YCAT + (size_t)m * DM + 512 + c) = pg8::pack8(s0 * rs, s1 * rs);
        }
    }
    grid.sync();

    {
        pg8::Gemm g{YCAT, Wout, 1024, 1024, 0, 0}; pg8::StaticOrder S; S.init(NTOK, 1024, G, bx);
        pg8::EpiF32 E{Yf, 1024, 0};
        pg8::gemm_phase<pg8::EpiF32, pg8::StaticOrder>(lds, g, S, E);
    }
    grid.sync();

    {
        f32x4 gn[4];
#pragma unroll
        for (int j = 0; j < 4; ++j) gn[j] = ((const f32x4*)p.in[18])[lane + 64 * j];
        for (int m = gw; m < NTOK; m += NGW) {
            const float* xrow = (m < NPROMPT) ? xp + (size_t)m * DM : xs + (size_t)(m - NPROMPT) * DM;
            f32x4 v[4], xv[4]; float s = 0.f;
#pragma unroll
            for (int j = 0; j < 4; ++j) { v[j] = ((const f32x4*)(Yf + (size_t)m * DM))[lane + 64 * j]; xv[j] = ((const f32x4*)xrow)[lane + 64 * j]; s += (v[j].x * v[j].x + v[j].y * v[j].y) + (v[j].z * v[j].z + v[j].w * v[j].w); }
            const float rstd = rsqrtf(wave_sum(s) * (1.f / DM) + EPS);
            float s1 = 0.f;
#pragma unroll
            for (int j = 0; j < 4; ++j) { v[j] = xv[j] + v[j] * rstd * gn[j]; ((f32x4*)(OUT + (size_t)m * DM))[lane + 64 * j] = v[j]; s1 += (v[j].x * v[j].x + v[j].y * v[j].y) + (v[j].z * v[j].z + v[j].w * v[j].w); }
            const float r1 = rsqrtf(wave_sum(s1) * (1.f / DM) + EPS);
            u32x2* o = (u32x2*)(H2 + (size_t)m * DM);
#pragma unroll
            for (int j = 0; j < 4; ++j) { u32x2 w; w.x = pk2(v[j].x * r1, v[j].y * r1); w.y = pk2(v[j].z * r1, v[j].w * r1); o[lane + 64 * j] = w; }
        }
    }
    grid.sync();

    {
        pg8::Gemm g{H2, Wup, 1024, 1024, 0, 0}; pg8::StaticOrder S; S.init(NTOK, DUP, G, bx);
        pg8::EpiAct E{ACT, EDGE, p.in[21], p.in[22], (LAS float*)(lds + XB_OFF)};
        pg8::gemm_phase<pg8::EpiAct, pg8::StaticOrder>(lds, g, S, E);
    }
    grid.sync();

    {
        const float* cw = p.in[21]; const float* cb = p.in[22];
        for (int it = gt; it < 384 * 2 * 704; it += NGT) {
            const int chg = it % 704, side = (it / 704) & 1, pm = it / 1408;
            const int m0 = 256 * pm + (side ? 255 : 0); int t, L; seqpos(m0, t, L);
            if ((side == 0 && t == 0) || (side == 1 && t == L - 1)) continue;
            const int ch = 4 * chg, colg = (ch >> 7) * 256 + (ch & 127);
            const float* rp = side ? EDGE + (size_t)(pm * 4 + 2) * DUP : EDGE + (size_t)((pm - 1) * 4 + 3) * DUP;
            const float* rc = side ? EDGE + (size_t)(pm * 4 + 3) * DUP : EDGE + (size_t)(pm * 4 + 0) * DUP;
            const float* rn = side ? EDGE + (size_t)((pm + 1) * 4 + 0) * DUP : EDGE + (size_t)(pm * 4 + 1) * DUP;
            f32x4 cv[2];
#pragma unroll
            for (int bj = 0; bj < 2; ++bj) { const int col = colg + 128 * bj, wcol = ch + bj * DFF;
                cv[bj] = *(const f32x4*)(cw + wcol) * *(const f32x4*)(rp + col) + *(const f32x4*)(cw + DUP + wcol) * *(const f32x4*)(rc + col) + *(const f32x4*)(cw + 2 * DUP + wcol) * *(const f32x4*)(rn + col) + *(const f32x4*)(cb + wcol); }
            u32x2 w; w.x = pk2(cv[0].x * sigmoidf_(cv[0].x) * cv[1].x, cv[0].y * sigmoidf_(cv[0].y) * cv[1].y); w.y = pk2(cv[0].z * sigmoidf_(cv[0].z) * cv[1].z, cv[0].w * sigmoidf_(cv[0].w) * cv[1].w);
            *(u32x2*)(ACT + (size_t)m0 * DFF + ch) = w;
        }
    }
    grid.sync();

    {
        pg8::Gemm g{ACT, Wdn, DFF, DFF, 0, 0}; pg8::StaticOrder S; S.init(NTOK, 1024, G, bx);
        pg8::EpiF32 E{Ff, 1024, 0};
        pg8::gemm_phase<pg8::EpiF32, pg8::StaticOrder>(lds, g, S, E);
    }
    grid.sync();

    {
        f32x4 gn[4];
#pragma unroll
        for (int j = 0; j < 4; ++j) gn[j] = ((const f32x4*)p.in[24])[lane + 64 * j];
        for (int m = gw; m < NTOK; m += NGW) {
            f32x4 v[4], xv[4]; float s = 0.f;
#pragma unroll
            for (int j = 0; j < 4; ++j) { v[j] = ((const f32x4*)(Ff + (size_t)m * DM))[lane + 64 * j]; xv[j] = ((const f32x4*)(OUT + (size_t)m * DM))[lane + 64 * j]; s += (v[j].x * v[j].x + v[j].y * v[j].y) + (v[j].z * v[j].z + v[j].w * v[j].w); }
            const float rstd = rsqrtf(wave_sum(s) * (1.f / DM) + EPS);
#pragma unroll
            for (int j = 0; j < 4; ++j) ((f32x4*)(OUT + (size_t)m * DM))[lane + 64 * j] = xv[j] + v[j] * rstd * gn[j];
        }
    }
}

extern "C" void kernel_launch(void* const* d_in, const int* in_sizes, int n_in, void* d_out, int out_size, void* d_ws, size_t ws_size, hipStream_t stream) {
    static int grid = 0;
    if (grid == 0) {
        int dev = 0, cus = 0, per_cu = 0;
        hipGetDevice(&dev);
        hipDeviceGetAttribute(&cus, hipDeviceAttributeMultiprocessorCount, dev);
        if (hipFuncSetAttribute((const void*)mk_fwd, hipFuncAttributeMaxDynamicSharedMemorySize, LDS_BYTES) != hipSuccess) { fprintf(stderr, "kernel_launch: hipFuncSetAttribute failed\n"); grid = -1; return; }
        if (hipOccupancyMaxActiveBlocksPerMultiprocessor(&per_cu, (const void*)mk_fwd, 512, LDS_BYTES) != hipSuccess || per_cu < 1) { fprintf(stderr, "kernel_launch: occupancy query says %d\n", per_cu); per_cu = 1; }
        (void)hipGetLastError();
        grid = cus * 1;
        if (n_in != 25 || ws_size < 1024 * MiB) { fprintf(stderr, "kernel_launch: unexpected n_in %d / ws %zu\n", n_in, ws_size); }
    }
    if (grid < 0) return;
    Params p{};
    for (int i = 0; i < 25; ++i) p.in[i] = (const float*)d_in[i];
    p.out = (float*)d_out; p.ws = (unsigned char*)d_ws;
    void* args[] = {&p};
    hipError_t e = hipLaunchCooperativeKernel((const void*)mk_fwd, dim3(grid), dim3(512), args, LDS_BYTES, stream);
    if (e != hipSuccess) fprintf(stderr, "cooperative launch failed: %s (grid %d)\n", hipGetErrorString(e), grid);
}
```

```cpp
#include <hip/hip_runtime.h>
#include <hip/hip_cooperative_groups.h>
#include <cstdio>
#include <cstdint>
namespace cg = cooperative_groups;

#define LAS __attribute__((address_space(3)))
typedef unsigned short bf16_t;
typedef short bf16x8 __attribute__((ext_vector_type(8)));
typedef float f32x4 __attribute__((ext_vector_type(4)));
typedef float f32x2 __attribute__((ext_vector_type(2)));
typedef unsigned u32x4 __attribute__((ext_vector_type(4)));
typedef unsigned u32x2 __attribute__((ext_vector_type(2)));

constexpr int NTOK = 98304, NPROMPT = 32768, DM = 1024, DZ3 = 1536, DFF = 2816, DUP = 5632;
constexpr int NCHUNK = 1536, UROW = 40960  , TPK = 1280;
constexpr float EPS = 1e-6f;
constexpr size_t MiB = 1u << 20;
constexpr size_t WS_WIN = 1 * MiB, WS_WGLU = 5 * MiB, WS_WOUT = 6 * MiB, WS_WUP = 8 * MiB, WS_WDN = 19 * MiB;
constexpr size_t WS_POW = 25 * MiB, WS_BBAR = 28 * MiB, WS_KT = 29 * MiB, WS_BIN = 33 * MiB, WS_TP = 49 * MiB;
constexpr size_t WS_H = 130 * MiB, WS_Z3 = 322 * MiB, WS_U = 610 * MiB, WS_ELOC = 730 * MiB, WS_YG = 778 * MiB, WS_YS = 874 * MiB;
constexpr size_t WS_YCAT = 130 * MiB, WS_Y = 322 * MiB, WS_H2 = 706 * MiB, WS_ACT = 25 * MiB, WS_EDGE = 898 * MiB, WS_F = 553 * MiB;
constexpr int LDS_BYTES = 147456, XB_OFF = 131072;

__device__ __forceinline__ unsigned f2bf(float f) { unsigned u = __builtin_bit_cast(unsigned, f); return (u + 0x7fffu + ((u >> 16) & 1u)) >> 16; }
__device__ __forceinline__ unsigned pk2(float lo, float hi) { return f2bf(lo) | (f2bf(hi) << 16); }
__device__ __forceinline__ float bflo(unsigned w) { return __builtin_bit_cast(float, w << 16); }
__device__ __forceinline__ float bfhi(unsigned w) { return __builtin_bit_cast(float, w & 0xffff0000u); }
__device__ __forceinline__ float wave_sum(float v) {
#pragma unroll
    for (int o = 1; o < 64; o <<= 1) v += __shfl_xor(v, o);
    return v;
}
__device__ __forceinline__ float sigmoidf_(float v) { return __builtin_amdgcn_rcpf(1.0f + __expf(-v)); }
__device__ __forceinline__ float gelu_tanh(float x) { const float u = 0.7978845608028654f * (x + 0.044715f * x * x * x); return x * sigmoidf_(2.0f * u); }
__device__ __forceinline__ void seqpos(int m, int& t, int& L) { if (m < NPROMPT) { t = m & 2047; L = 2048; } else { t = m & 4095; L = 4096; } }

namespace pg8 {
constexpr int BM = 256, BK = 64, HALF = 128, HTB = HALF * BK * 2, STAGE_BYTES = 8 * HTB, NXCD = 8, WGM = 8;
__host__ __device__ __forceinline__ int lds_byte(int r, int c) { const int st = (r >> 4) * 2 + (c >> 5), rr = r & 15, cc = c & 31, ob = rr * 64 + cc * 2; return st * 1024 + (ob ^ (((ob >> 9) & 1) << 5)); }
__host__ __device__ __forceinline__ void stage_rc(int b, int& R, int& C) { const int st = b / 1024, sb = b % 1024, swz = sb ^ (((sb >> 9) & 1) << 5); R = (st >> 1) * 16 + swz / 64; C = (st & 1) * 32 + (swz % 64) / 2; }
__host__ __device__ __forceinline__ int perm32(int rho) { const int n = rho >> 4, i = rho & 15; return 8 * (i >> 2) + 4 * n + (i & 3); }

struct Unit { int pm, pn, b; };
struct Gemm { const bf16_t* A; const bf16_t* Bt; int lda, K; size_t bsA, bsB; };

struct StaticOrder {
    int nM, nN, nwg, G, c;
    __device__ void init(int M, int N, int G_, int c_) { nM = M / BM; nN = N / BM; nwg = nM * nN; G = G_; c = c_; }
    __device__ bool next(int i, Unit& u) const {
        const long L = (long)i * G + c; if (L >= nwg) return false;
        int wgid = (int)L; { const int q = nwg / NXCD, r = nwg % NXCD, xcd = wgid % NXCD, off = wgid / NXCD; wgid = (xcd < r ? xcd * (q + 1) : r * (q + 1) + (xcd - r) * q) + off; }
        const int nig = WGM * nN, gid = wgid / nig, fm = gid * WGM, gsz = (nM - fm) < WGM ? (nM - fm) : WGM;
        u.pm = fm + ((wgid % nig) % gsz); u.pn = (wgid % nig) / gsz; u.b = 0; return true;
    }
};
struct BatchOrder {
    int nM, nN, per, total, G, c;
    __device__ void init(int nM_, int nN_, int nb, int G_, int c_) { nM = nM_; nN = nN_; per = nM_ * nN_; total = per * nb; G = G_; c = c_; }
    __device__ bool next(int i, Unit& u) const {
        const int L = i * G + c; if (L >= total) return false;
        u.b = L / per; const int r = L % per; u.pm = r % nM; u.pn = r / nM; return true;
    }
};

__device__ __forceinline__ unsigned cvt_pk_bf16(float lo, float hi) { unsigned r; asm volatile("v_cvt_pk_bf16_f32 %0, %1, %2" : "=v"(r) : "v"(lo), "v"(hi)); return r; }

template <class Epi, class Sched, bool ALIGN_EPI = true, bool SP2 = true>
__device__ __forceinline__ void gemm_phase(LAS unsigned char* lds, const Gemm g, const Sched& S, const Epi& E) {
    const int tid = threadIdx.x, wid = __builtin_amdgcn_readfirstlane(tid >> 6), lane = tid & 63, wr = wid >> 2, wc = wid & 3, fr = lane & 15, fq = lane >> 4;
    const int K = g.K, nt = K / BK, lda = g.lda;
    unsigned voffA[2], voffB[2];
#pragma unroll
    for (int i = 0; i < 2; ++i) { int R, C; stage_rc(tid * 16 + i * 8192, R, C); const int Rb = Epi::PERM ? ((R & ~31) + perm32(R & 31)) : R;
        voffA[i] = (unsigned)(R * lda + C) * 2u; voffB[i] = (unsigned)(Rb * K + C) * 2u; }
    const size_t kstep = (size_t)(BK * 2);
    const size_t hstepA = (size_t)HALF * lda * 2, hstepB = (size_t)HALF * K * 2;
    const size_t tstepA = 2 * hstepA, tstepB = 2 * hstepB;
    const unsigned ldsw = (unsigned)wid * 1024u;
    const int aoff = lds_byte(wr * 64 + fr, fq * 8), boff = lds_byte(wc * 32 + fr, fq * 8);
#define PG8_SA(b, h) (((b) * 2 + (h)) * HTB)
#define PG8_SB(b, h) ((4 + (b) * 2 + (h)) * HTB)
#define PG8_STAGE(bufoff, gbase, voff) do { _Pragma("unroll") for (int _i = 0; _i < 2; ++_i) \
        __builtin_amdgcn_global_load_lds((const unsigned*)((const char*)(gbase) + (voff)[_i]), (LAS unsigned*)(lds + (bufoff) + ldsw + _i * 8192), 16, 0, 0); } while (0)
#define PG8_LDA(dst, b, h) do { _Pragma("unroll") for (int m = 0; m < 4; ++m) _Pragma("unroll") for (int k = 0; k < 2; ++k) dst[m][k] = *(const LAS bf16x8*)(lds + PG8_SA(b, h) + aoff + m * 2048 + k * 1024); } while (0)
#define PG8_LDB(dst, b, h) do { _Pragma("unroll") for (int n = 0; n < 2; ++n) _Pragma("unroll") for (int k = 0; k < 2; ++k) dst[n][k] = *(const LAS bf16x8*)(lds + PG8_SB(b, h) + boff + n * 2048 + k * 1024); } while (0)
#define PG8_MMA(ai, bj, At, Bt) do { __builtin_amdgcn_s_setprio(1); _Pragma("unroll") for (int m = 0; m < 4; ++m) _Pragma("unroll") for (int n = 0; n < 2; ++n) _Pragma("unroll") for (int k = 0; k < 2; ++k) \
        acc[ai][bj][m][n] = __builtin_amdgcn_mfma_f32_16x16x32_bf16(Bt[n][k], At[m][k], acc[ai][bj][m][n], 0, 0, 0); __builtin_amdgcn_s_setprio(0); } while (0)
#define PG8_WAIT_V(n) asm volatile("s_waitcnt vmcnt(" #n ")" ::: "memory")
#define PG8_WAIT_L(n) asm volatile("s_waitcnt lgkmcnt(" #n ")" ::: "memory")
#define PG8_BAR __builtin_amdgcn_s_barrier()
#define PG8_SCHED __builtin_amdgcn_sched_barrier(0)
    Unit cur, nxt; int ui = 0;
    if (!S.next(0, cur)) return;
    f32x4 acc[2][2][4][2];
#pragma unroll
    for (int a = 0; a < 2; ++a)
#pragma unroll
        for (int b = 0; b < 2; ++b)
#pragma unroll
            for (int m = 0; m < 4; ++m)
#pragma unroll
                for (int n = 0; n < 2; ++n) acc[a][b][m][n] = (f32x4){0.f, 0.f, 0.f, 0.f};
    bf16x8 At[4][2], B0[2][2], B1[2][2];
    const char* cA = (const char*)(g.A + (size_t)cur.b * g.bsA) + (size_t)cur.pm * tstepA;
    const char* cB = (const char*)(g.Bt + (size_t)cur.b * g.bsB) + (size_t)cur.pn * tstepB;
    if constexpr (SP2) {
        PG8_STAGE(PG8_SB(0, 0), cB, voffB); PG8_STAGE(PG8_SB(0, 1), cB + hstepB, voffB); PG8_STAGE(PG8_SA(0, 0), cA, voffA); PG8_STAGE(PG8_SA(0, 1), cA + hstepA, voffA);
        if (wr == 1) PG8_BAR;
        PG8_WAIT_V(2); PG8_BAR;
        PG8_STAGE(PG8_SB(1, 0), cB + kstep, voffB); PG8_STAGE(PG8_SA(1, 0), cA + kstep, voffA); PG8_STAGE(PG8_SB(1, 1), cB + hstepB + kstep, voffB);
        PG8_WAIT_V(6); PG8_BAR;
    } else {
        PG8_STAGE(PG8_SB(0, 0), cB, voffB); PG8_STAGE(PG8_SA(0, 0), cA, voffA); PG8_STAGE(PG8_SB(0, 1), cB + hstepB, voffB); PG8_STAGE(PG8_SA(0, 1), cA + hstepA, voffA);
        if (wr == 1) PG8_BAR;
        PG8_WAIT_V(4); PG8_BAR;
        PG8_STAGE(PG8_SB(1, 0), cB + kstep, voffB); PG8_STAGE(PG8_SA(1, 0), cA + kstep, voffA); PG8_STAGE(PG8_SB(1, 1), cB + hstepB + kstep, voffB);
        PG8_WAIT_V(6); PG8_BAR;
    }
    for (;;) {
        const bool has_next = S.next(ui + 1, nxt);
        const char* nA = has_next ? (const char*)(g.A + (size_t)nxt.b * g.bsA) + (size_t)nxt.pm * tstepA : cA;
        const char* nB = has_next ? (const char*)(g.Bt + (size_t)nxt.b * g.bsB) + (size_t)nxt.pn * tstepB : cB;
        for (int t = 0; t < nt; t += 2) {
            const bool last = (t == nt - 2);
            const char* a1 = cA + (size_t)(t + 1) * kstep;
            const char* a2 = last ? nA : cA + (size_t)(t + 2) * kstep; const char* b2 = last ? nB : cB + (size_t)(t + 2) * kstep;
            const char* a3 = a2 + kstep; const char* b3 = b2 + kstep;
            if constexpr (SP2) {
            PG8_LDB(B0, 0, 0); PG8_LDB(B1, 0, 1); PG8_SCHED; PG8_LDA(At, 0, 0); PG8_STAGE(PG8_SA(1, 1), a1 + hstepA, voffA);
            PG8_WAIT_V(8); PG8_WAIT_L(0); PG8_BAR; PG8_MMA(0, 0, At, B0); PG8_MMA(0, 1, At, B1); PG8_BAR; PG8_SCHED;
            PG8_LDA(At, 0, 1); PG8_STAGE(PG8_SB(0, 0), b2, voffB); PG8_STAGE(PG8_SB(0, 1), b2 + hstepB, voffB); PG8_STAGE(PG8_SA(0, 0), a2, voffA);
            PG8_WAIT_V(8); PG8_WAIT_L(0); PG8_BAR; PG8_MMA(1, 0, At, B0); PG8_MMA(1, 1, At, B1); PG8_BAR; PG8_SCHED;
            PG8_LDB(B0, 1, 0); PG8_LDB(B1, 1, 1); PG8_SCHED; PG8_LDA(At, 1, 0); PG8_STAGE(PG8_SA(0, 1), a2 + hstepA, voffA);
            PG8_WAIT_V(8); PG8_WAIT_L(0); PG8_BAR; PG8_MMA(0, 0, At, B0); PG8_MMA(0, 1, At, B1); PG8_BAR; PG8_SCHED;
            PG8_LDA(At, 1, 1); PG8_STAGE(PG8_SB(1, 0), b3, voffB); PG8_STAGE(PG8_SB(1, 1), b3 + hstepB, voffB); PG8_STAGE(PG8_SA(1, 0), a3, voffA);
            PG8_WAIT_V(8); PG8_WAIT_L(0); PG8_BAR; PG8_MMA(1, 0, At, B0); PG8_MMA(1, 1, At, B1); PG8_BAR; PG8_SCHED;
            } else {
            PG8_LDB(B0, 0, 0); PG8_SCHED; PG8_LDA(At, 0, 0); PG8_STAGE(PG8_SA(1, 1), a1 + hstepA, voffA);
            PG8_WAIT_L(8); PG8_BAR; PG8_WAIT_L(0); PG8_MMA(0, 0, At, B0); PG8_BAR; PG8_SCHED;
            PG8_LDB(B1, 0, 1); PG8_STAGE(PG8_SB(0, 0), b2, voffB);
            PG8_BAR; PG8_WAIT_L(0); PG8_MMA(0, 1, At, B1); PG8_BAR;
            PG8_LDA(At, 0, 1); PG8_STAGE(PG8_SA(0, 0), a2, voffA);
            PG8_BAR; PG8_WAIT_L(0); PG8_MMA(1, 0, At, B0); PG8_BAR; PG8_SCHED;
            PG8_STAGE(PG8_SB(0, 1), b2 + hstepB, voffB);
            PG8_WAIT_V(6); PG8_BAR; PG8_MMA(1, 1, At, B1); PG8_BAR;
            PG8_LDB(B0, 1, 0); PG8_SCHED; PG8_LDA(At, 1, 0); PG8_STAGE(PG8_SA(0, 1), a2 + hstepA, voffA);
            PG8_WAIT_L(8); PG8_BAR; PG8_WAIT_L(0); PG8_MMA(0, 0, At, B0); PG8_BAR; PG8_SCHED;
            PG8_LDB(B1, 1, 1); PG8_STAGE(PG8_SB(1, 0), b3, voffB);
            PG8_BAR; PG8_WAIT_L(0); PG8_MMA(0, 1, At, B1); PG8_BAR;
            PG8_LDA(At, 1, 1); PG8_STAGE(PG8_SA(1, 0), a3, voffA);
            PG8_BAR; PG8_WAIT_L(0); PG8_MMA(1, 0, At, B0); PG8_BAR; PG8_SCHED;
            PG8_STAGE(PG8_SB(1, 1), b3 + hstepB, voffB);
            PG8_WAIT_V(6); PG8_BAR; PG8_MMA(1, 1, At, B1); PG8_BAR;
            }
        }
        if constexpr (ALIGN_EPI) { if (wr == 0) PG8_BAR; }
        E(acc, cur, wr, wc, fr, fq);
        if (!has_next) break;
#pragma unroll
        for (int a = 0; a < 2; ++a)
#pragma unroll
            for (int b = 0; b < 2; ++b)
#pragma unroll
                for (int m = 0; m < 4; ++m)
#pragma unroll
                    for (int n = 0; n < 2; ++n) acc[a][b][m][n] = (f32x4){0.f, 0.f, 0.f, 0.f};
        cur = nxt; cA = nA; cB = nB; ++ui;
        if constexpr (ALIGN_EPI) { if (wr == 1) PG8_BAR; }
    }
    PG8_WAIT_V(0);
    if constexpr (!ALIGN_EPI) { if (wr == 0) PG8_BAR; }
    PG8_BAR;
#undef PG8_SA
#undef PG8_SB
#undef PG8_STAGE
#undef PG8_LDA
#undef PG8_LDB
#undef PG8_MMA
#undef PG8_WAIT_V
#undef PG8_WAIT_L
#undef PG8_BAR
#undef PG8_SCHED
}

__device__ __forceinline__ u32x4 pack8(const f32x4 v0, const f32x4 v1) { u32x4 w; w.x = cvt_pk_bf16(v0[0], v0[1]); w.y = cvt_pk_bf16(v0[2], v0[3]); w.z = cvt_pk_bf16(v1[0], v1[1]); w.w = cvt_pk_bf16(v1[2], v1[3]); return w; }
__device__ __forceinline__ void unpack8(const u32x4 w, f32x4& v0, f32x4& v1) { v0 = (f32x4){bflo(w.x), bfhi(w.x), bflo(w.y), bfhi(w.y)}; v1 = (f32x4){bflo(w.z), bfhi(w.z), bflo(w.w), bfhi(w.w)}; }

struct EpiF32 {
    static constexpr bool PERM = false;
    float* C; int ldc; int boff;
    __device__ __forceinline__ void operator()(const f32x4 (&acc)[2][2][4][2], const Unit& u, int wr, int wc, int fr, int fq) const {
        const int row0 = u.pm * BM + wr * 64 + fr, col0 = u.pn * BM + wc * 32 + 4 * fq + u.b * boff;
#pragma unroll
        for (int ai = 0; ai < 2; ++ai)
#pragma unroll
            for (int m = 0; m < 4; ++m) { float* rowp = C + (size_t)(row0 + ai * HALF + m * 16) * ldc + col0;
#pragma unroll
                for (int bj = 0; bj < 2; ++bj)
#pragma unroll
                    for (int n = 0; n < 2; ++n) *(f32x4*)(rowp + bj * HALF + n * 16) = acc[ai][bj][m][n]; }
    }
};
struct EpiBf16 {
    static constexpr bool PERM = true;
    bf16_t* O; int ldc;
    __device__ __forceinline__ void operator()(const f32x4 (&acc)[2][2][4][2], const Unit& u, int wr, int wc, int fr, int fq) const {
        const int row0 = u.pm * BM + wr * 64 + fr, col0 = u.pn * BM + wc * 32 + 8 * fq;
#pragma unroll
        for (int ai = 0; ai < 2; ++ai)
#pragma unroll
            for (int m = 0; m < 4; ++m) { bf16_t* rowp = O + (size_t)(row0 + ai * HALF + m * 16) * ldc + col0;
#pragma unroll
                for (int bj = 0; bj < 2; ++bj) *(u32x4*)(rowp + bj * HALF) = pack8(acc[ai][bj][m][0], acc[ai][bj][m][1]); }
    }
};
struct EpiZ {
    static constexpr bool PERM = true;
    bf16_t* z3; bf16_t* U;
    __device__ __forceinline__ void operator()(const f32x4 (&acc)[2][2][4][2], const Unit& u, int wr, int wc, int fr, int fq) const {
        const int row0 = u.pm * BM + wr * 64 + fr;
#pragma unroll
        for (int ai = 0; ai < 2; ++ai)
#pragma unroll
            for (int m = 0; m < 4; ++m) { const int row = row0 + ai * HALF + m * 16;
#pragma unroll
                for (int bj = 0; bj < 2; ++bj) { const int c0 = u.pn * BM + bj * HALF + wc * 32 + 8 * fq;
                    const u32x4 w = pack8(acc[ai][bj][m][0], acc[ai][bj][m][1]);
                    if (u.pn < 6) *(u32x4*)(z3 + (size_t)row * DZ3 + c0) = w;
                    else { const int cz = c0 - DZ3; *(u32x4*)(U + (size_t)(row >> 6) * UROW + (cz >> 4) * TPK + (row & 63) * 16 + (cz & 15)) = w; } } }
    }
};
struct EpiT {
    static constexpr bool PERM = true;
    const bf16_t* U; const float* dsk; bf16_t* yg;
    __device__ __forceinline__ void operator()(const f32x4 (&acc)[2][2][4][2], const Unit& u, int wr, int wc, int fr, int fq) const {
        const int row0 = u.pm * BM + wr * 64 + fr, g = u.b;
#pragma unroll
        for (int bj = 0; bj < 2; ++bj) { const int c0 = u.pn * BM + bj * HALF + wc * 32 + 8 * fq; const int i = c0 >> 4, h0 = c0 & 15, ch = g * 16 + h0;
            const f32x4 d0 = *(const f32x4*)(dsk + ch), d1 = *(const f32x4*)(dsk + ch + 4);
#pragma unroll
            for (int ai = 0; ai < 2; ++ai)
#pragma unroll
                for (int m = 0; m < 4; ++m) { const int row = row0 + ai * HALF + m * 16;
                    const u32x4 uw = *(const u32x4*)(U + (size_t)row * UROW + g * TPK + c0); f32x4 u0, u1; unpack8(uw, u0, u1);
                    f32x4 v0 = acc[ai][bj][m][0] + d0 * u0, v1 = acc[ai][bj][m][1] + d1 * u1;
#pragma unroll
                    for (int j = 0; j < 4; ++j) { v0[j] = gelu_tanh(v0[j]); v1[j] = gelu_tanh(v1[j]); }
                    *(u32x4*)(yg + (size_t)(row * 64 + i) * 512 + ch) = pack8(v0, v1); } }
    }
};
struct EpiGlu {
    static constexpr bool PERM = true;
    const bf16_t* yg; const float* bias; bf16_t* ys;
    __device__ __forceinline__ void operator()(const f32x4 (&acc)[2][2][4][2], const Unit& u, int wr, int wc, int fr, int fq) const {
        const int row0 = u.pm * BM + wr * 64 + fr;
#pragma unroll
        for (int bj = 0; bj < 2; ++bj) { const int c0 = u.pn * BM + bj * HALF + wc * 32 + 8 * fq;
            const f32x4 b0 = *(const f32x4*)(bias + c0), b1 = *(const f32x4*)(bias + c0 + 4);
#pragma unroll
            for (int ai = 0; ai < 2; ++ai)
#pragma unroll
                for (int m = 0; m < 4; ++m) { const int row = row0 + ai * HALF + m * 16;
                    const u32x4 yw = *(const u32x4*)(yg + (size_t)row * 512 + c0); f32x4 y0, y1; unpack8(yw, y0, y1);
                    f32x4 v0 = acc[ai][bj][m][0] + b0, v1 = acc[ai][bj][m][1] + b1;
#pragma unroll
                    for (int j = 0; j < 4; ++j) { v0[j] = y0[j] * sigmoidf_(v0[j]); v1[j] = y1[j] * sigmoidf_(v1[j]); }
                    *(u32x4*)(ys + (size_t)row * 512 + c0) = pack8(v0, v1); } }
    }
};
__device__ __forceinline__ f32x4 shfl4(const f32x4 v, int src) { f32x4 r; r[0] = __shfl(v[0], src); r[1] = __shfl(v[1], src); r[2] = __shfl(v[2], src); r[3] = __shfl(v[3], src); return r; }
struct EpiAct {
    static constexpr bool PERM = true;
    bf16_t* act; float* edge; const float* cw; const float* cb; LAS float* xb;
    __device__ __forceinline__ void operator()(const f32x4 (&acc)[2][2][4][2], const Unit& u, int wr, int wc, int fr, int fq) const {
        const int lane = threadIdx.x & 63;
        const int lc0 = 32 * wc + 8 * fq;
#pragma unroll
        for (int ai = 0; ai < 2; ++ai)
#pragma unroll
            for (int bj = 0; bj < 2; ++bj)
#pragma unroll
                for (int n = 0; n < 2; ++n) {
                    if (fr == 0) *(LAS f32x4*)(xb + ((2 * ai + wr) * 2 + 0) * 256 + 128 * bj + lc0 + 4 * n) = acc[ai][bj][0][n];
                    if (fr == 15) *(LAS f32x4*)(xb + ((2 * ai + wr) * 2 + 1) * 256 + 128 * bj + lc0 + 4 * n) = acc[ai][bj][3][n];
                }
        if (wr == 0 && fr < 2) {
#pragma unroll
            for (int bj = 0; bj < 2; ++bj)
#pragma unroll
                for (int n = 0; n < 2; ++n) *(f32x4*)(edge + (size_t)(u.pm * 4 + fr) * DUP + u.pn * 256 + 128 * bj + lc0 + 4 * n) = acc[0][bj][0][n];
        }
        if (wr == 1 && fr >= 14) {
#pragma unroll
            for (int bj = 0; bj < 2; ++bj)
#pragma unroll
                for (int n = 0; n < 2; ++n) *(f32x4*)(edge + (size_t)(u.pm * 4 + 2 + (fr - 14)) * DUP + u.pn * 256 + 128 * bj + lc0 + 4 * n) = acc[1][bj][3][n];
        }
        asm volatile("s_waitcnt lgkmcnt(0)" ::: "memory"); __builtin_amdgcn_s_barrier(); asm volatile("" ::: "memory");
        const int sprev = (lane & 48) | ((lane - 1) & 15), snext = (lane & 48) | ((lane + 1) & 15);
        const int ch0 = 128 * u.pn + lc0;
#pragma unroll
        for (int n = 0; n < 2; ++n) {
            const int ch = ch0 + 4 * n;
            f32x4 w0[2], w1[2], w2[2], bb[2];
#pragma unroll
            for (int bj = 0; bj < 2; ++bj) { const int col = ch + bj * DFF;
                w0[bj] = *(const f32x4*)(cw + col); w1[bj] = *(const f32x4*)(cw + DUP + col); w2[bj] = *(const f32x4*)(cw + 2 * DUP + col); bb[bj] = *(const f32x4*)(cb + col); }
#pragma unroll
            for (int ai = 0; ai < 2; ++ai) {
                const int q = 2 * ai + wr;
#pragma unroll
                for (int m = 0; m < 4; ++m) {
                    f32x4 cv[2];
#pragma unroll
                    for (int bj = 0; bj < 2; ++bj) {
                        const f32x4 cur = acc[ai][bj][m][n];
                        f32x4 tp = cur, tn = cur;
                        if (m > 0) { const f32x4 o = acc[ai][bj][m > 0 ? m - 1 : 0][n]; tp = (fr == 15) ? o : cur; }
                        if (m < 3) { const f32x4 o = acc[ai][bj][m < 3 ? m + 1 : 3][n]; tn = (fr == 0) ? o : cur; }
                        f32x4 prev = shfl4(tp, sprev), next = shfl4(tn, snext);
                        if (m == 0) { f32x4 top = (f32x4){0.f, 0.f, 0.f, 0.f}; if (q > 0) top = *(const LAS f32x4*)(xb + ((q - 1) * 2 + 1) * 256 + 128 * bj + lc0 + 4 * n); prev = (fr == 0) ? top : prev; }
                        if (m == 3) { f32x4 bot = (f32x4){0.f, 0.f, 0.f, 0.f}; if (q < 3) bot = *(const LAS f32x4*)(xb + ((q + 1) * 2 + 0) * 256 + 128 * bj + lc0 + 4 * n); next = (fr == 15) ? bot : next; }
                        cv[bj] = w0[bj] * prev + w1[bj] * cur + w2[bj] * next + bb[bj];
                    }
                    f32x4 a;
#pragma unroll
                    for (int j = 0; j < 4; ++j) a[j] = cv[0][j] * sigmoidf_(cv[0][j]) * cv[1][j];
                    u32x2 w; w.x = cvt_pk_bf16(a[0], a[1]); w.y = cvt_pk_bf16(a[2], a[3]);
                    const int row = u.pm * BM + ai * HALF + wr * 64 + m * 16 + fr;
                    *(u32x2*)(act + (size_t)row * DFF + ch) = w;
                }
            }
        }
    }
};
}

struct Params { const float* in[25]; float* out; unsigned char* ws; };

__device__ __forceinline__ void transpose_item(const float* W, int K, int N, bf16_t* WT, int drow0, const float* gain, LAS float* scr, int k0, int n0, int lane) {
#pragma unroll 8
    for (int i = 0; i < 32; ++i) { const int kk = 2 * i + (lane >> 5); float w = W[(size_t)(k0 + kk) * N + n0 + (lane & 31)]; if (gain) w *= gain[k0 + kk]; scr[kk * 33 + (lane & 31)] = w; }
    asm volatile("s_waitcnt lgkmcnt(0)" ::: "memory");
    const int c = lane & 7;
#pragma unroll
    for (int j = 0; j < 4; ++j) { const int n = (lane >> 3) + 8 * j; const LAS float* s = scr + (8 * c) * 33 + n;
        u32x4 o; o.x = pk2(s[0 * 33], s[1 * 33]); o.y = pk2(s[2 * 33], s[3 * 33]); o.z = pk2(s[4 * 33], s[5 * 33]); o.w = pk2(s[6 * 33], s[7 * 33]);
        *(u32x4*)(WT + (size_t)(drow0 + n) * K + k0 + 8 * c) = o; }
    asm volatile("s_waitcnt lgkmcnt(0)" ::: "memory");
}

__global__ void __launch_bounds__(512, 2) mk_fwd(Params p) {
    extern __shared__ __attribute__((aligned(16))) unsigned char lds_raw[];
    LAS unsigned char* lds = (LAS unsigned char*)lds_raw;
    cg::grid_group grid = cg::this_grid();
    const int tid = threadIdx.x, lane = tid & 63, wave = __builtin_amdgcn_readfirstlane(tid >> 6);
    const int G = gridDim.x, bx = blockIdx.x;
    const int gw = bx * 8 + wave, NGW = G * 8;
    const int gt = bx * 512 + tid, NGT = G * 512;
    unsigned char* ws = p.ws;
    const float* xp = p.in[0]; const float* xs = p.in[1];
    bf16_t* Win = (bf16_t*)(ws + WS_WIN); bf16_t* Wglu = (bf16_t*)(ws + WS_WGLU); bf16_t* Wout = (bf16_t*)(ws + WS_WOUT); bf16_t* Wup = (bf16_t*)(ws + WS_WUP); bf16_t* Wdn = (bf16_t*)(ws + WS_WDN);
    f32x2* POW = (f32x2*)(ws + WS_POW); f32x2* BBAR = (f32x2*)(ws + WS_BBAR); float* KT = (float*)(ws + WS_KT); bf16_t* BIN = (bf16_t*)(ws + WS_BIN); bf16_t* TP = (bf16_t*)(ws + WS_TP);
    bf16_t* Hb = (bf16_t*)(ws + WS_H); bf16_t* Z3 = (bf16_t*)(ws + WS_Z3); bf16_t* Ub = (bf16_t*)(ws + WS_U); float* ELOC = (float*)(ws + WS_ELOC);
    bf16_t* YG = (bf16_t*)(ws + WS_YG); bf16_t* YS = (bf16_t*)(ws + WS_YS); bf16_t* YCAT = (bf16_t*)(ws + WS_YCAT); bf16_t* Yb = (bf16_t*)(ws + WS_Y);
    bf16_t* H2 = (bf16_t*)(ws + WS_H2); bf16_t* ACT = (bf16_t*)(ws + WS_ACT); float* EDGE = (float*)(ws + WS_EDGE); bf16_t* Fb = (bf16_t*)(ws + WS_F);
    float* OUT = p.out;

    {
        LAS float* scr = (LAS float*)(lds + wave * 16384);
        constexpr int I_IN = 16 * 64, I_GLU = 8 * 16, I_OUT = 16 * 32, I_UP = 16 * 176, I_DN = 44 * 32, NITEMS = I_IN + I_GLU + I_OUT + I_UP + I_DN;
        for (int it = gw; it < NITEMS; it += NGW) {
            int r = it;
            if (r < I_IN) { const int kb = r / 64, nb = r % 64; transpose_item(p.in[3], 1024, 2048, Win, nb * 32, p.in[2], scr, kb * 64, nb * 32, lane); continue; } r -= I_IN;
            if (r < I_GLU) { const int kb = r / 16, nb = r % 16; transpose_item(p.in[13], 512, 512, Wglu, nb * 32, nullptr, scr, kb * 64, nb * 32, lane); continue; } r -= I_GLU;
            if (r < I_OUT) { const int kb = r / 32, nb = r % 32; const float* gn = (kb < 8) ? p.in[15] : (p.in[16] - 512); transpose_item(p.in[17], 1024, 1024, Wout, nb * 32, gn, scr, kb * 64, nb * 32, lane); continue; } r -= I_OUT;
            if (r < I_UP) { const int kb = r / 176, nb = r % 176; const int n0 = nb * 32; const int ch0 = n0 < DFF ? n0 : n0 - DFF; const int drow0 = (ch0 >> 7) * 256 + (ch0 & 127) + (n0 < DFF ? 0 : 128);
                transpose_item(p.in[20], 1024, DUP, Wup, drow0, p.in[19], scr, kb * 64, n0, lane); continue; } r -= I_UP;
            { const int kb = r / 32, nb = r % 32; transpose_item(p.in[23], DFF, 1024, Wdn, nb * 32, nullptr, scr, kb * 64, nb * 32, lane); }
        }
        for (int mb = gw; mb < NTOK; mb += 2 * NGW) {
            f32x4 v[2][4]; float s[2] = {0.f, 0.f};
#pragma unroll
            for (int r = 0; r < 2; ++r) { const int m = mb + r * NGW; if (m < NTOK) { const float* xrow = (m < NPROMPT) ? xp + (size_t)m * DM : xs + (size_t)(m - NPROMPT) * DM;
#pragma unroll
                for (int j = 0; j < 4; ++j) v[r][j] = ((const f32x4*)xrow)[lane + 64 * j]; } }
#pragma unroll
            for (int r = 0; r < 2; ++r) { const int m = mb + r * NGW; if (m < NTOK) {
#pragma unroll
                for (int j = 0; j < 4; ++j) s[r] += (v[r][j].x * v[r][j].x + v[r][j].y * v[r][j].y) + (v[r][j].z * v[r][j].z + v[r][j].w * v[r][j].w);
                const float rstd = rsqrtf(wave_sum(s[r]) * (1.f / DM) + EPS);
                u32x2* o = (u32x2*)(Hb + (size_t)m * DM);
#pragma unroll
                for (int j = 0; j < 4; ++j) { u32x2 w; w.x = pk2(v[r][j].x * rstd, v[r][j].y * rstd); w.y = pk2(v[r][j].z * rstd, v[r][j].w * rstd); o[lane + 64 * j] = w; } } }
        }
        for (int idx = gt; idx < 4096; idx += NGT) {
            const float lr = p.in[5][idx], li = p.in[6][idx], dt = expf(p.in[7][idx >> 6]);
            const float e = expf(lr * dt), th = li * dt; const float lbr = e * cosf(th), lbi = e * sinf(th);
            const float den = 1.0f / (lr * lr + li * li); const float ar = lbr - 1.0f;
            const float cr = (ar * lr + lbi * li) * den, ci = (lbi * lr - ar * li) * den;
            for (int h = 0; h < 16; ++h) { const float br = p.in[8][idx * 16 + h], bi = p.in[9][idx * 16 + h]; BBAR[idx * 16 + h] = (f32x2){cr * br - ci * bi, cr * bi + ci * br}; }
            float pr = 1.f, pi = 0.f;
            for (int k = 0; k <= 64; ++k) { POW[idx * 65 + k] = (f32x2){pr, pi}; const float nr = pr * lbr - pi * lbi, ni = pr * lbi + pi * lbr; pr = nr; pi = ni; }
        }
    }
    grid.sync();

    {
        for (int e = gt; e < 2 * 32 * 64 * 256; e += NGT) {
            const int hp = e & 15, h = (e >> 4) & 15, d = (e >> 8) & 63, dg = e >> 14;
            const float* cre = p.in[10] + dg * 1024 + h * 64; const float* cim = p.in[11] + dg * 1024 + h * 64;
            float s = 0.f;
            for (int pp = 0; pp < 64; ++pp) { const int idx = dg * 64 + pp; const f32x2 pw = POW[idx * 65 + d], bb = BBAR[idx * 16 + hp]; const float cr = cre[pp], ci = cim[pp];
                s += (cr * pw.x - ci * pw.y) * bb.x - (cr * pw.y + ci * pw.x) * bb.y; }
            KT[e] = s;
        }
        for (int e = gt; e < 32 * 256 * 128; e += NGT) {
            const int k0 = (e & 127) * 8, n = (e >> 7) & 255, g = e >> 15; const int j = k0 >> 4, h0 = k0 & 15, pp = n & 63, dir = n >> 7;
            const int idx = (dir * 32 + g) * 64 + pp; const f32x2 pw = POW[idx * 65 + (dir ? j : 63 - j)]; const bool im = (n >> 6) & 1;
            float v[8];
#pragma unroll
            for (int q = 0; q < 8; ++q) { const f32x2 bb = BBAR[idx * 16 + h0 + q]; v[q] = im ? (pw.x * bb.y + pw.y * bb.x) : (pw.x * bb.x - pw.y * bb.y); }
            u32x4 o; o.x = pk2(v[0], v[1]); o.y = pk2(v[2], v[3]); o.z = pk2(v[4], v[5]); o.w = pk2(v[6], v[7]);
            *(u32x4*)(BIN + (size_t)(g * 256 + n) * 1024 + k0) = o;
        }
        for (int e = gt; e < 32 * 1024 * 32; e += NGT) {
            const int q0 = (e & 31) * 8, n = (e >> 5) & 1023, g = e >> 15; const int i = n >> 4, h = n & 15, blk = q0 >> 6, dir = blk >> 1; const bool im = blk & 1;
            float v[8];
#pragma unroll
            for (int q = 0; q < 8; ++q) { const int pp = (q0 + q) & 63; const int idx = (dir * 32 + g) * 64 + pp; const f32x2 pw = POW[idx * 65 + (dir ? 64 - i : i + 1)];
                const float cr = p.in[10][(dir * 32 + g) * 1024 + h * 64 + pp], ci = p.in[11][(dir * 32 + g) * 1024 + h * 64 + pp];
                v[q] = im ? -(cr * pw.y + ci * pw.x) : (cr * pw.x - ci * pw.y); }
            u32x4 o; o.x = pk2(v[0], v[1]); o.y = pk2(v[2], v[3]); o.z = pk2(v[4], v[5]); o.w = pk2(v[6], v[7]);
            *(u32x4*)(TP + (size_t)(g * 1024 + n) * TPK + 1024 + q0) = o;
        }
        pg8::Gemm g{Hb, Win, 1024, 1024, 0, 0}; pg8::StaticOrder S; S.init(NTOK, 2048, G, bx);
        pg8::EpiZ E{Z3, Ub};
        pg8::gemm_phase<pg8::EpiZ, pg8::StaticOrder>(lds, g, S, E);
    }
    grid.sync();

    {
        for (int e = gt; e < 32 * 1024 * 128; e += NGT) {
            const int k0 = (e & 127) * 8, n = (e >> 7) & 1023, g = e >> 17; const int i = n >> 4, h = n & 15, j = k0 >> 4, h0 = k0 & 15;
            f32x4 a, b;
            if (i > j) { const float* s = KT + ((size_t)((0 * 32 + g) * 64 + (i - j)) * 256 + h * 16 + h0); a = *(const f32x4*)s; b = *(const f32x4*)(s + 4); }
            else if (i < j) { const float* s = KT + ((size_t)((1 * 32 + g) * 64 + (j - i)) * 256 + h * 16 + h0); a = *(const f32x4*)s; b = *(const f32x4*)(s + 4); }
            else { const float* s = KT + ((size_t)((0 * 32 + g) * 64) * 256 + h * 16 + h0); const float* s2 = KT + ((size_t)((1 * 32 + g) * 64) * 256 + h * 16 + h0);
                a = *(const f32x4*)s + *(const f32x4*)s2; b = *(const f32x4*)(s + 4) + *(const f32x4*)(s2 + 4); }
            u32x4 o; o.x = pk2(a.x, a.y); o.y = pk2(a.z, a.w); o.z = pk2(b.x, b.y); o.w = pk2(b.z, b.w);
            *(u32x4*)(TP + (size_t)(g * 1024 + n) * TPK + k0) = o;
        }
        pg8::Gemm g{Ub, BIN, UROW, 1024, (size_t)TPK, (size_t)256 * 1024}; pg8::BatchOrder S; S.init(NCHUNK / 256, 1, 32, G, bx);
        pg8::EpiF32 E{ELOC, 32 * 256, 256};
        pg8::gemm_phase<pg8::EpiF32, pg8::BatchOrder>(lds, g, S, E);
    }
    grid.sync();

    {
        for (int id = gt; id < 32 * 32 * 2 * 64; id += NGT) {
            const int pp = id & 63, dir = (id >> 6) & 1, g = (id >> 7) & 31, seq = id >> 12;
            const int cb = seq < 16 ? seq * 32 : 512 + (seq - 16) * 64, nc = seq < 16 ? 32 : 64;
            const f32x2 lt = POW[((dir * 32 + g) * 64 + pp) * 65 + 64];
            float sr = 0.f, si = 0.f;
            for (int c8 = 0; c8 < nc; c8 += 8) {
                float er[8], ei[8];
#pragma unroll
                for (int q = 0; q < 8; ++q) { const int c = dir ? (nc - 1 - (c8 + q)) : (c8 + q); const float* ep = ELOC + ((size_t)(cb + c) * 32 + g) * 256 + dir * 128 + pp; er[q] = ep[0]; ei[q] = ep[64]; }
#pragma unroll
                for (int q = 0; q < 8; ++q) { const int c = dir ? (nc - 1 - (c8 + q)) : (c8 + q); bf16_t* up = Ub + (size_t)(cb + c) * UROW + g * TPK + 1024 + dir * 128 + pp;
                    up[0] = (bf16_t)f2bf(sr); up[64] = (bf16_t)f2bf(si);
                    const float nr = lt.x * sr - lt.y * si + er[q], ni = lt.x * si + lt.y * sr + ei[q]; sr = nr; si = ni; }
            }
        }
    }
    grid.sync();

    {
        pg8::Gemm g{Ub, TP, UROW, TPK, (size_t)TPK, (size_t)1024 * TPK}; pg8::BatchOrder S; S.init(NCHUNK / 256, 4, 32, G, bx);
        pg8::EpiT E{Ub, p.in[12], YG};
        pg8::gemm_phase<pg8::EpiT, pg8::BatchOrder>(lds, g, S, E);
    }
    grid.sync();

    {
        pg8::Gemm g{YG, Wglu, 512, 512, 0, 0}; pg8::StaticOrder S; S.init(NTOK, 512, G, bx);
        pg8::EpiGlu E{YG, p.in[14], YS};
        pg8::gemm_phase<pg8::EpiGlu, pg8::StaticOrder>(lds, g, S, E);
    }
    grid.sync();

    {
        const int c = 8 * lane;
        const float* cw = p.in[4];
        f32x4 w0a = *(const f32x4*)(cw + c), w0b = *(const f32x4*)(cw + c + 4), w1a = *(const f32x4*)(cw + 512 + c), w1b = *(const f32x4*)(cw + 512 + c + 4), w2a = *(const f32x4*)(cw + 1024 + c), w2b = *(const f32x4*)(cw + 1024 + c + 4);
        for (int m = gw; m < NTOK; m += NGW) {
            int t, L; seqpos(m, t, L);
            const bf16_t* zr = Z3 + (size_t)m * DZ3;
            const u32x4 zero = (u32x4){0u, 0u, 0u, 0u};
            const u32x4 zbw = *(const u32x4*)(zr + c), zc0 = *(const u32x4*)(zr + 512 + c), zx0 = *(const u32x4*)(zr + 1024 + c);
            u32x4 zcm = zero, zxm = zero, zcp = zero, zxp = zero;
            if (t > 0) { zcm = *(const u32x4*)(zr - DZ3 + 512 + c); zxm = *(const u32x4*)(zr - DZ3 + 1024 + c); }
            if (t < L - 1) { zcp = *(const u32x4*)(zr + DZ3 + 512 + c); zxp = *(const u32x4*)(zr + DZ3 + 1024 + c); }
            const u32x4 ysw = *(const u32x4*)(YS + (size_t)m * 512 + c);
            f32x4 b0, b1, a0, a1, x0, x1, am0, am1, xm0, xm1, ap0, ap1, xp0, xp1;
            pg8::unpack8(zbw, b0, b1); pg8::unpack8(zc0, a0, a1); pg8::unpack8(zx0, x0, x1); pg8::unpack8(zcm, am0, am1); pg8::unpack8(zxm, xm0, xm1); pg8::unpack8(zcp, ap0, ap1); pg8::unpack8(zxp, xp0, xp1);
            f32x4 y0 = b0 * (w0a * (am0 * xm0) + w1a * (a0 * x0) + w2a * (ap0 * xp0));
            f32x4 y1 = b1 * (w0b * (am1 * xm1) + w1b * (a1 * x1) + w2b * (ap1 * xp1));
            float ss = (y0.x * y0.x + y0.y * y0.y) + (y0.z * y0.z + y0.w * y0.w) + (y1.x * y1.x + y1.y * y1.y) + (y1.z * y1.z + y1.w * y1.w);
            const float rc = rsqrtf(wave_sum(ss) * (1.f / 512.f) + EPS);
            *(u32x4*)(YCAT + (size_t)m * DM + c) = pg8::pack8(y0 * rc, y1 * rc);
            f32x4 s0, s1; pg8::unpack8(ysw, s0, s1);
            float s2 = (s0.x * s0.x + s0.y * s0.y) + (s0.z * s0.z + s0.w * s0.w) + (s1.x * s1.x + s1.y * s1.y) + (s1.z * s1.z + s1.w * s1.w);
            const float rs = rsqrtf(wave_sum(s2) * (1.f / 512.f) + EPS);
            *(u32x4*)(YCAT + (size_t)m * DM + 512 + c) = pg8::pack8(s0 * rs, s1 * rs);
        }
    }
    grid.sync();

    {
        pg8::Gemm g{YCAT, Wout, 1024, 1024, 0, 0}; pg8::StaticOrder S; S.init(NTOK, 1024, G, bx);
        pg8::EpiBf16 E{Yb, 1024};
        pg8::gemm_phase<pg8::EpiBf16, pg8::StaticOrder>(lds, g, S, E);
    }
    grid.sync();

    {
        f32x4 gn[4];
#pragma unroll
        for (int j = 0; j < 4; ++j) gn[j] = ((const f32x4*)p.in[18])[lane + 64 * j];
        for (int mb = gw; mb < NTOK; mb += 2 * NGW) {
            f32x4 v[2][4], xv[2][4];
#pragma unroll
            for (int r = 0; r < 2; ++r) { const int m = mb + r * NGW; if (m < NTOK) { const float* xrow = (m < NPROMPT) ? xp + (size_t)m * DM : xs + (size_t)(m - NPROMPT) * DM;
#pragma unroll
                for (int j = 0; j < 4; ++j) { const u32x2 yw = ((const u32x2*)(Yb + (size_t)m * DM))[lane + 64 * j]; v[r][j] = (f32x4){bflo(yw.x), bfhi(yw.x), bflo(yw.y), bfhi(yw.y)}; xv[r][j] = ((const f32x4*)xrow)[lane + 64 * j]; } } }
#pragma unroll
            for (int r = 0; r < 2; ++r) { const int m = mb + r * NGW; if (m < NTOK) {
                float s = 0.f;
#pragma unroll
                for (int j = 0; j < 4; ++j) s += (v[r][j].x * v[r][j].x + v[r][j].y * v[r][j].y) + (v[r][j].z * v[r][j].z + v[r][j].w * v[r][j].w);
                const float rstd = rsqrtf(wave_sum(s) * (1.f / DM) + EPS);
                float s1 = 0.f;
#pragma unroll
                for (int j = 0; j < 4; ++j) { v[r][j] = xv[r][j] + v[r][j] * rstd * gn[j]; ((f32x4*)(OUT + (size_t)m * DM))[lane + 64 * j] = v[r][j]; s1 += (v[r][j].x * v[r][j].x + v[r][j].y * v[r][j].y) + (v[r][j].z * v[r][j].z + v[r][j].w * v[r][j].w); }
                const float r1 = rsqrtf(wave_sum(s1) * (1.f / DM) + EPS);
                u32x2* o = (u32x2*)(H2 + (size_t)m * DM);
#pragma unroll
                for (int j = 0; j < 4; ++j) { u32x2 w; w.x = pk2(v[r][j].x * r1, v[r][j].y * r1); w.y = pk2(v[r][j].z * r1, v[r][j].w * r1); o[lane + 64 * j] = w; } } }
        }
    }
    grid.sync();

    {
        pg8::Gemm g{H2, Wup, 1024, 1024, 0, 0}; pg8::StaticOrder S; S.init(NTOK, DUP, G, bx);
        pg8::EpiAct E{ACT, EDGE, p.in[21], p.in[22], (LAS float*)(lds + XB_OFF)};
        pg8::gemm_phase<pg8::EpiAct, pg8::StaticOrder>(lds, g, S, E);
    }
    grid.sync();

    {
        const float* cw = p.in[21]; const float* cb = p.in[22];
        for (int it = gt; it < 384 * 2 * 704; it += NGT) {
            const int chg = it % 704, side = (it / 704) & 1, pm = it / 1408;
            const int m0 = 256 * pm + (side ? 255 : 0); int t, L; seqpos(m0, t, L);
            if ((side == 0 && t == 0) || (side == 1 && t == L - 1)) continue;
            const int ch = 4 * chg, colg = (ch >> 7) * 256 + (ch & 127);
            const float* rp = side ? EDGE + (size_t)(pm * 4 + 2) * DUP : EDGE + (size_t)((pm - 1) * 4 + 3) * DUP;
            const float* rc = side ? EDGE + (size_t)(pm * 4 + 3) * DUP : EDGE + (size_t)(pm * 4 + 0) * DUP;
            const float* rn = side ? EDGE + (size_t)((pm + 1) * 4 + 0) * DUP : EDGE + (size_t)(pm * 4 + 1) * DUP;
            f32x4 cv[2];
#pragma unroll
            for (int bj = 0; bj < 2; ++bj) { const int col = colg + 128 * bj, wcol = ch + bj * DFF;
                cv[bj] = *(const f32x4*)(cw + wcol) * *(const f32x4*)(rp + col) + *(const f32x4*)(cw + DUP + wcol) * *(const f32x4*)(rc + col) + *(const f32x4*)(cw + 2 * DUP + wcol) * *(const f32x4*)(rn + col) + *(const f32x4*)(cb + wcol); }
            u32x2 w; w.x = pk2(cv[0].x * sigmoidf_(cv[0].x) * cv[1].x, cv[0].y * sigmoidf_(cv[0].y) * cv[1].y); w.y = pk2(cv[0].z * sigmoidf_(cv[0].z) * cv[1].z, cv[0].w * sigmoidf_(cv[0].w) * cv[1].w);
            *(u32x2*)(ACT + (size_t)m0 * DFF + ch) = w;
        }
    }
    grid.sync();

    {
        pg8::Gemm g{ACT, Wdn, DFF, DFF, 0, 0}; pg8::StaticOrder S; S.init(NTOK, 1024, G, bx);
        pg8::EpiBf16 E{Fb, 1024};
        pg8::gemm_phase<pg8::EpiBf16, pg8::StaticOrder>(lds, g, S, E);
    }
    grid.sync();

    {
        f32x4 gn[4];
#pragma unroll
        for (int j = 0; j < 4; ++j) gn[j] = ((const f32x4*)p.in[24])[lane + 64 * j];
        for (int mb = gw; mb < NTOK; mb += 2 * NGW) {
            f32x4 v[2][4], xv[2][4];
#pragma unroll
            for (int r = 0; r < 2; ++r) { const int m = mb + r * NGW; if (m < NTOK) {
#pragma unroll
                for (int j = 0; j < 4; ++j) { const u32x2 fw = ((const u32x2*)(Fb + (size_t)m * DM))[lane + 64 * j]; v[r][j] = (f32x4){bflo(fw.x), bfhi(fw.x), bflo(fw.y), bfhi(fw.y)}; xv[r][j] = ((const f32x4*)(OUT + (size_t)m * DM))[lane + 64 * j]; } } }
#pragma unroll
            for (int r = 0; r < 2; ++r) { const int m = mb + r * NGW; if (m < NTOK) {
                float s = 0.f;
#pragma unroll
                for (int j = 0; j < 4; ++j) s += (v[r][j].x * v[r][j].x + v[r][j].y * v[r][j].y) + (v[r][j].z * v[r][j].z + v[r][j].w * v[r][j].w);
                const float rstd = rsqrtf(wave_sum(s) * (1.f / DM) + EPS);
#pragma unroll
                for (int j = 0; j < 4; ++j) ((f32x4*)(OUT + (size_t)m * DM))[lane + 64 * j] = xv[r][j] + v[r][j] * rstd * gn[j]; } }
        }
    }
}

extern "C" void kernel_launch(void* const* d_in, const int* in_sizes, int n_in, void* d_out, int out_size, void* d_ws, size_t ws_size, hipStream_t stream) {
    static int grid = 0;
    if (grid == 0) {
        int dev = 0, cus = 0, per_cu = 0;
        (void)hipGetDevice(&dev);
        (void)hipDeviceGetAttribute(&cus, hipDeviceAttributeMultiprocessorCount, dev);
        if (hipFuncSetAttribute((const void*)mk_fwd, hipFuncAttributeMaxDynamicSharedMemorySize, LDS_BYTES) != hipSuccess) { fprintf(stderr, "kernel_launch: hipFuncSetAttribute failed\n"); grid = -1; return; }
        if (hipOccupancyMaxActiveBlocksPerMultiprocessor(&per_cu, (const void*)mk_fwd, 512, LDS_BYTES) != hipSuccess || per_cu < 1) { fprintf(stderr, "kernel_launch: occupancy query says %d\n", per_cu); per_cu = 1; }
        (void)hipGetLastError();
        grid = cus * 1;
        if (n_in != 25 || ws_size < 1024 * MiB) { fprintf(stderr, "kernel_launch: unexpected n_in %d / ws %zu\n", n_in, ws_size); }
    }
    if (grid < 0) return;
    Params p{};
    for (int i = 0; i < 25; ++i) p.in[i] = (const float*)d_in[i];
    p.out = (float*)d_out; p.ws = (unsigned char*)d_ws;
    void* args[] = {&p};
    hipError_t e = hipLaunchCooperativeKernel((const void*)mk_fwd, dim3(grid), dim3(512), args, LDS_BYTES, stream);
    if (e != hipSuccess) fprintf(stderr, "cooperative launch failed: %s (grid %d)\n", hipGetErrorString(e), grid);
}
```
